# Optimizing an MI355X kernel written in HIP

```python
import math
import jax, jax.numpy as jnp
from jax import lax
import numpy as np

D_MODEL = 1024
BATCH = 2
SEQ = 16384
DEPTH = 4

N_MIXERS = 2
SSM_GROUP = 16
SSM_GROUPS = D_MODEL // SSM_GROUP
SSM_STATE = 64
ATTN_HEADS = 8
ATTN_HD = D_MODEL // ATTN_HEADS // 2
Q_BLOCK = 128
REL_BUCKETS = 32
REL_MAX_EXACT = REL_BUCKETS // 2
REL_MAX_DIST = 128
D_FF = 2816
N_EXPERTS = 8
TOP_K = 2
RMS_EPS = 1e-6
N_SSM_LAYERS = (DEPTH + 1) // 2
N_ATTN_LAYERS = DEPTH // 2
N_DENSE_LAYERS = (DEPTH + 1) // 2
N_MOE_LAYERS = DEPTH // 2

kernel_name = "hybrid_s5_diffattn_moe_trunk"


def rms_norm(x, g):
    xf = x.astype(jnp.float32)
    y = xf * lax.rsqrt(jnp.mean(xf * xf, axis=-1, keepdims=True) + RMS_EPS)
    return (y * g.astype(jnp.float32)).astype(x.dtype)


def swiglu(h, w_gate_up, w_down):
    g, u = jnp.split(h @ w_gate_up, 2, axis=-1)
    return (jax.nn.silu(g) * u) @ w_down


def s5_mixer(u, a_re, a_im, log_dt, b_re, b_im, c_re, c_im, d_skip):
    f32 = jnp.float32
    L = u.shape[1]
    dt = jnp.exp(log_dt.astype(f32))[:, None]
    ar = a_re.astype(f32); ai = a_im.astype(f32)
    mag = jnp.exp(ar * dt)
    ab_re = mag * jnp.cos(ai * dt)
    ab_im = mag * jnp.sin(ai * dt)
    den = ar * ar + ai * ai
    nr = ab_re - 1.0; ni = ab_im
    coef_re = (nr * ar + ni * ai) / den
    coef_im = (ni * ar - nr * ai) / den
    br = b_re.astype(f32); bi = b_im.astype(f32)
    bb_re = coef_re[..., None] * br - coef_im[..., None] * bi
    bb_im = coef_re[..., None] * bi + coef_im[..., None] * br
    cr = c_re.astype(f32); ci = c_im.astype(f32)

    def combine(e1, e2):
        a1r, a1i, b1r, b1i = e1
        a2r, a2i, b2r, b2i = e2
        return (a2r * a1r - a2i * a1i,
                a2r * a1i + a2i * a1r,
                a2r * b1r - a2i * b1i + b2r,
                a2r * b1i + a2i * b1r + b2i)

    def per_sequence(ub):
        ug = ub.astype(f32).reshape(L, SSM_GROUPS, SSM_GROUP)
        x_re = jnp.einsum('lgc,gpc->lgp', ug, bb_re)
        x_im = jnp.einsum('lgc,gpc->lgp', ug, bb_im)
        a_re_l = jnp.broadcast_to(ab_re, x_re.shape)
        a_im_l = jnp.broadcast_to(ab_im, x_im.shape)
        _, _, s_re, s_im = lax.associative_scan(combine, (a_re_l, a_im_l, x_re, x_im), axis=0)
        y = jnp.einsum('lgp,gcp->lgc', s_re, cr) - jnp.einsum('lgp,gcp->lgc', s_im, ci)
        return y.reshape(L, D_MODEL)

    y = lax.map(per_sequence, u)
    y = y + d_skip.astype(f32) * u.astype(f32)
    return y.astype(u.dtype)


def rel_bucket(n):
    n = jnp.maximum(n, 0)
    is_small = n < REL_MAX_EXACT
    nf = jnp.maximum(n, 1).astype(jnp.float32)
    large = REL_MAX_EXACT + (jnp.log(nf / REL_MAX_EXACT) / math.log(REL_MAX_DIST / REL_MAX_EXACT)
                             * (REL_BUCKETS - REL_MAX_EXACT)).astype(jnp.int32)
    large = jnp.minimum(large, REL_BUCKETS - 1)
    return jnp.where(is_small, n, large)


def diff_attention(h, w_qkv, lq1, lk1, lq2, lk2, subln_g, w_o, rel_bias, lambda_init):
    B_, L, _ = h.shape
    q, k, v = jnp.split(h @ w_qkv, 3, axis=-1)
    q = q.reshape(B_, L, ATTN_HEADS, 2, ATTN_HD).transpose(0, 2, 3, 1, 4)
    k = k.reshape(B_, L, ATTN_HEADS, 2, ATTN_HD).transpose(0, 2, 3, 1, 4)
    v = v.reshape(B_, L, ATTN_HEADS, 2 * ATTN_HD).transpose(0, 2, 1, 3)
    f32 = jnp.float32
    lam = (jnp.exp(jnp.sum(lq1.astype(f32) * lk1.astype(f32)))
           - jnp.exp(jnp.sum(lq2.astype(f32) * lk2.astype(f32))) + lambda_init)
    n_blocks = L // Q_BLOCK
    q_blocks = q.reshape(B_, ATTN_HEADS, 2, n_blocks, Q_BLOCK, ATTN_HD).transpose(3, 0, 1, 2, 4, 5)
    k_pos = jnp.arange(L, dtype=jnp.int32)
    scale = ATTN_HD ** -0.5
    bias_table = rel_bias.astype(f32).T

    def block(args):
        qb, start = args
        q_pos = start + jnp.arange(Q_BLOCK, dtype=jnp.int32)
        rel = q_pos[:, None] - k_pos[None, :]
        s = jnp.einsum('bhmqd,bhmkd->bhmqk', qb, k).astype(f32) * scale
        s = s + bias_table[:, rel_bucket(rel)][None, :, None]
        s = jnp.where((rel >= 0)[None, None, None], s, -jnp.inf)
        p = jax.nn.softmax(s, axis=-1)
        p = p[:, :, 0] - lam * p[:, :, 1]
        return jnp.einsum('bhqk,bhkd->bhqd', p.astype(v.dtype), v)

    starts = jnp.arange(n_blocks, dtype=jnp.int32) * Q_BLOCK
    o = lax.map(block, (q_blocks, starts))
    o = o.transpose(1, 2, 0, 3, 4).reshape(B_, ATTN_HEADS, L, 2 * ATTN_HD)
    o = rms_norm(o, subln_g) * (1.0 - lambda_init)
    o = o.transpose(0, 2, 1, 3).reshape(B_, L, D_MODEL)
    return o @ w_o


def moe_ffn(h, router, w_gate_up, w_down):
    shape = h.shape
    hf = h.reshape(-1, D_MODEL)
    logits = (hf @ router).astype(jnp.float32)
    top_vals, top_idx = lax.top_k(logits, TOP_K)
    gates = jax.nn.softmax(top_vals, axis=-1)
    combine = jnp.sum(jax.nn.one_hot(top_idx, N_EXPERTS, dtype=jnp.float32) * gates[..., None], axis=1)
    y = jnp.zeros_like(hf)
    for e in range(N_EXPERTS):
        y = y + combine[:, e:e + 1].astype(hf.dtype) * swiglu(hf, w_gate_up[e], w_down[e])
    return y.reshape(shape)


def setup_inputs(seed: int = 0) -> dict:
    key = jax.random.key(seed)
    ks = jax.random.split(key, 24)
    nrm = jax.random.normal
    D, G, P, C, F, E = D_MODEL, SSM_GROUPS, SSM_STATE, SSM_GROUP, D_FF, N_EXPERTS
    NA, NB, ND, NM = N_SSM_LAYERS, N_ATTN_LAYERS, N_DENSE_LAYERS, N_MOE_LAYERS
    a_im0 = jnp.pi * jnp.arange(P, dtype=jnp.float32)
    return {
        "x": nrm(ks[0], (BATCH, SEQ, D), jnp.float32),
        "norm_mix_g": 1.0 + 0.01 * nrm(ks[1], (DEPTH, D)),
        "norm_ffn_g": 1.0 + 0.01 * nrm(ks[2], (DEPTH, D)),
        "final_norm_g": 1.0 + 0.01 * nrm(ks[3], (D,)),
        "ssm_a_re": -0.5 + 0.01 * nrm(ks[4], (NA, G, P)),
        "ssm_a_im": a_im0 + 0.01 * nrm(ks[5], (NA, G, P)),
        "ssm_log_dt": jax.random.uniform(ks[6], (NA, G), minval=math.log(1e-3), maxval=math.log(1e-1)),
        "ssm_b_re": nrm(ks[7], (NA, G, P, C)) * (2 * C) ** -0.5,
        "ssm_b_im": nrm(ks[8], (NA, G, P, C)) * (2 * C) ** -0.5,
        "ssm_c_re": nrm(ks[9], (NA, G, C, P)) * (2 * P) ** -0.5,
        "ssm_c_im": nrm(ks[10], (NA, G, C, P)) * (2 * P) ** -0.5,
        "ssm_d": nrm(ks[11], (NA, D)),
        "ssm_w_glu": nrm(ks[12], (NA, D, 2 * D)) * D ** -0.5,
        "attn_w_qkv": nrm(ks[13], (NB, D, 3 * D)) * D ** -0.5,
        "attn_lambda_q1": 0.1 * nrm(ks[14], (NB, ATTN_HD)),
        "attn_lambda_k1": 0.1 * nrm(ks[15], (NB, ATTN_HD)),
        "attn_lambda_q2": 0.1 * nrm(ks[16], (NB, ATTN_HD)),
        "attn_lambda_k2": 0.1 * nrm(ks[17], (NB, ATTN_HD)),
        "attn_subln_g": 1.0 + 0.01 * nrm(ks[18], (NB, 2 * ATTN_HD)),
        "attn_w_o": nrm(ks[19], (NB, D, D)) * D ** -0.5,
        "rel_bias": 0.5 * nrm(ks[20], (REL_BUCKETS, ATTN_HEADS)),
        "ffn_w_gate_up": nrm(ks[21], (ND, D, 2 * F)) * D ** -0.5,
        "ffn_w_down": nrm(ks[22], (ND, F, D)) * F ** -0.5,
        "moe_router": nrm(jax.random.fold_in(ks[23], 0), (NM, D, E)) * D ** -0.5,
        "moe_w_gate_up": nrm(jax.random.fold_in(ks[23], 1), (NM, E, D, 2 * F)) * D ** -0.5,
        "moe_w_down": nrm(jax.random.fold_in(ks[23], 2), (NM, E, F, D)) * F ** -0.5,
    }


def reference(x, norm_mix_g, norm_ffn_g, final_norm_g,
              ssm_a_re, ssm_a_im, ssm_log_dt, ssm_b_re, ssm_b_im, ssm_c_re, ssm_c_im, ssm_d, ssm_w_glu,
              attn_w_qkv, attn_lambda_q1, attn_lambda_k1, attn_lambda_q2, attn_lambda_k2,
              attn_subln_g, attn_w_o, rel_bias,
              ffn_w_gate_up, ffn_w_down, moe_router, moe_w_gate_up, moe_w_down):
    for i in range(DEPTH):
        j = i // 2
        h = rms_norm(x, norm_mix_g[i])
        if i % N_MIXERS == 0:
            y = s5_mixer(h, ssm_a_re[j], ssm_a_im[j], ssm_log_dt[j], ssm_b_re[j], ssm_b_im[j],
                         ssm_c_re[j], ssm_c_im[j], ssm_d[j])
            a, g = jnp.split(jax.nn.gelu(y) @ ssm_w_glu[j], 2, axis=-1)
            x = x + a * jax.nn.sigmoid(g)
        else:
            lambda_init = 0.8 - 0.6 * math.exp(-0.3 * i)
            x = x + diff_attention(h, attn_w_qkv[j], attn_lambda_q1[j], attn_lambda_k1[j],
                                   attn_lambda_q2[j], attn_lambda_k2[j], attn_subln_g[j],
                                   attn_w_o[j], rel_bias, lambda_init)
        h = rms_norm(x, norm_ffn_g[i])
        if i % 2 == 0:
            x = x + swiglu(h, ffn_w_gate_up[j], ffn_w_down[j])
        else:
            x = x + moe_ffn(h, moe_router[j], moe_w_gate_up[j], moe_w_down[j])
    return rms_norm(x, final_norm_g)
```

```cpp
#include <hip/hip_runtime.h>
#include <hip/hip_bf16.h>
#include <cstdio>
#include <cstdint>
#include <cmath>

#ifndef MK_PER_PHASE
#define MK_PER_PHASE 0
#endif

#ifndef PH_MASK
#define PH_MASK 0xffffffffu
#endif
#define PHON(k) (((PH_MASK) >> (k)) & 1u)
#ifndef PH_DOUBLE
#define PH_DOUBLE 0u
#endif
#define PHREP(k) ((((PH_DOUBLE) >> (k)) & 1u) ? 2 : 1)
#define GAS __attribute__((address_space(1)))
#define LAS __attribute__((address_space(3)))
typedef unsigned short bf16_t;
typedef short bf16x8 __attribute__((ext_vector_type(8)));
typedef short s16x4 __attribute__((ext_vector_type(4)));
typedef float f32x4 __attribute__((ext_vector_type(4)));
typedef float f32x2 __attribute__((ext_vector_type(2)));
typedef float f32x16 __attribute__((ext_vector_type(16)));
typedef unsigned u32x4 __attribute__((ext_vector_type(4)));
typedef unsigned u32x2 __attribute__((ext_vector_type(2)));
typedef int i32x4 __attribute__((ext_vector_type(4)));
typedef int i32x8 __attribute__((ext_vector_type(8)));
typedef GAS unsigned gu32;
#define RLX_AGENT __ATOMIC_RELAXED, __HIP_MEMORY_SCOPE_AGENT

constexpr int D = 1024, BATCH = 2, SEQ = 16384, T = BATCH * SEQ, FF = 2816, NE = 8;
constexpr int SSM_G = 64, SSM_P = 64, SSM_C = 16, NCHUNK = 64, CHUNK = 256;
constexpr float RMS_EPS = 1e-6f;
constexpr float LOG2E = 1.4426950408889634f;
constexpr int NWAVES = 8;
constexpr int MOE_ROWS = 2 * T + NE * 256;

constexpr size_t MiB = 1u << 20;
constexpr size_t WS_CTL = 0, CTL_ZERO_BYTES = 1 * MiB;
constexpr size_t SZ_WGLU = (size_t)2048 * 1024 * 2, SZ_WQKV = (size_t)3072 * 1024 * 2, SZ_WO = (size_t)1024 * 1024 * 2, SZ_WGU = (size_t)5632 * 1024 * 2, SZ_WDN = (size_t)1024 * 2816 * 2;
constexpr size_t WS_WGLU = 1 * MiB;
constexpr size_t WS_WQKV = WS_WGLU + 2 * SZ_WGLU;
constexpr size_t WS_WO = WS_WQKV + 2 * SZ_WQKV;
constexpr size_t WS_WGU = WS_WO + 2 * SZ_WO;
constexpr size_t WS_WDN = WS_WGU + 2 * SZ_WGU;
constexpr size_t WS_MGU = WS_WDN + 2 * SZ_WDN;
constexpr size_t WS_MDN = WS_MGU + 16 * SZ_WGU;
constexpr size_t WS_WEND = WS_MDN + 16 * SZ_WDN;
constexpr size_t WS_XN = (WS_WEND + MiB - 1) / MiB * MiB;
constexpr size_t WS_XR = WS_XN + (size_t)T * D * 2;
constexpr size_t WS_YG = WS_XR + (size_t)T * D * 2;
constexpr size_t WS_EB = WS_YG + (size_t)T * D * 2;
constexpr size_t WS_LIST = WS_EB + 4 * MiB;
constexpr size_t WS_TOK = WS_LIST + (size_t)2 * NE * T * 4;
constexpr size_t WS_SSQ = WS_TOK + (size_t)2 * T * 16;
constexpr size_t WS_YM = WS_SSQ + (size_t)T * 8 * 4;
constexpr size_t WS_RA = (WS_YM + (size_t)MOE_ROWS * D * 2 + MiB - 1) / MiB * MiB;
constexpr size_t WS_Q = WS_RA, WS_K = WS_Q + (size_t)T * D * 2, WS_V = WS_K + (size_t)T * D * 2, WS_OM = WS_V + (size_t)T * D * 2;
constexpr size_t WS_HID = WS_RA;
constexpr size_t WS_END = WS_RA + (size_t)MOE_ROWS * FF * 2;
static_assert(WS_OM + (size_t)T * 2048 * 2 <= WS_END, "overlay");
constexpr int CW_BAR = 4096;
constexpr int CW_CNT = 16384;
constexpr int CW_ATTQ = 20480;

constexpr int RING_BYTES = 147456;
constexpr int LDSCTL_OFF = RING_BYTES, LDS_BYTES = RING_BYTES + 1024;

#define LDS_WAIT() asm volatile("s_waitcnt lgkmcnt(0)" ::: "memory")
#define VM_WAIT() asm volatile("s_waitcnt vmcnt(0)" ::: "memory")

__device__ __forceinline__ unsigned cvt_pk_bf16(float lo, float hi) { unsigned r; asm volatile("v_cvt_pk_bf16_f32 %0, %1, %2" : "=v"(r) : "v"(lo), "v"(hi)); return r; }
__device__ __forceinline__ unsigned cvt_pk_fp8x4(float a, float b, float c, float d) {
    a = __builtin_amdgcn_fmed3f(a, -440.f, 440.f); b = __builtin_amdgcn_fmed3f(b, -440.f, 440.f); c = __builtin_amdgcn_fmed3f(c, -440.f, 440.f); d = __builtin_amdgcn_fmed3f(d, -440.f, 440.f);
    int p = __builtin_amdgcn_cvt_pk_fp8_f32(a, b, 0, false); p = __builtin_amdgcn_cvt_pk_fp8_f32(c, d, p, true); return (unsigned)p; }
constexpr float F8_W_MUL = 256.f, F8_X_MUL = 16.f, F8_H_MUL = 8.f;
constexpr int F8_W_SC = 127 - 8, F8_X_SC = 127 - 4, F8_H_SC = 127 - 3;
static_assert(F8_H_MUL == 8.f, "the up half MFMA scale (+3) carries F8_H_MUL");
constexpr float F8_GATE_FOLD = -1.4426950408889634f, F8_UP_FOLD = -0.6931471805599453f;
__device__ __forceinline__ float bf2f(unsigned short h) { return __uint_as_float(((unsigned)h) << 16); }
__device__ __forceinline__ float fast_exp2(float x) { return __builtin_amdgcn_exp2f(x); }
__device__ __forceinline__ float fast_rcp(float x) { return __builtin_amdgcn_rcpf(x); }
__device__ __forceinline__ float sigmoidf_(float x) { return fast_rcp(1.0f + fast_exp2(-x * LOG2E)); }
__device__ __forceinline__ float gelu_tanh(float x) { const float z = 0.7978845608028654f * (x + 0.044715f * x * x * x); return x * fast_rcp(1.0f + fast_exp2(-2.0f * LOG2E * z)); }
__device__ __forceinline__ int opaque_tid(int wv) { int l = (int)__builtin_amdgcn_mbcnt_hi(~0u, __builtin_amdgcn_mbcnt_lo(~0u, 0u)); asm volatile("" : "+v"(l)); return wv * 64 + l; }
template <int M> __device__ __forceinline__ float swz_xor(float v) { return __int_as_float(__builtin_amdgcn_ds_swizzle(__float_as_int(v), (M << 10) | 0x1f)); }
__device__ __forceinline__ float half_lo(float v) { auto rr = __builtin_amdgcn_permlane32_swap(__float_as_uint(v), __float_as_uint(v), false, false); return __uint_as_float(rr[0]); }
__device__ __forceinline__ float half_hi(float v) { auto rr = __builtin_amdgcn_permlane32_swap(__float_as_uint(v), __float_as_uint(v), false, false); return __uint_as_float(rr[1]); }
template <int CTRL> __device__ __forceinline__ float dpp_mov(float v) { return __int_as_float(__builtin_amdgcn_update_dpp(0, __float_as_int(v), CTRL, 0xf, 0xf, false)); }
__device__ __forceinline__ float row_sum16(float v) { v += dpp_mov<0x128>(v); v += dpp_mov<0x124>(v); v += dpp_mov<0x122>(v); v += dpp_mov<0x121>(v); return v; }
__device__ __forceinline__ float swap16_add(float x, float y) { auto rr = __builtin_amdgcn_permlane16_swap(__float_as_uint(x), __float_as_uint(y), false, false); return __uint_as_float(rr[0]) + __uint_as_float(rr[1]); }
__device__ __forceinline__ float swap32_add(float x, float y) { auto rr = __builtin_amdgcn_permlane32_swap(__float_as_uint(x), __float_as_uint(y), false, false); return __uint_as_float(rr[0]) + __uint_as_float(rr[1]); }
__device__ __forceinline__ float wave_sum(float v) { v = row_sum16(v); v = swap16_add(v, v); return swap32_add(v, v); }

#define XB_TMO      128
#define XB_XCNT(j)  (256  + 64 * (j))
#define XB_XSUB(j)  (1280 + 64 * (j))
#define XB_XGEN(j)  (2304 + 64 * (j))
#define XB_TOP      3328
#define XB_TOPGEN   3392
#define XCD_BAR_WORDS 3456
#define XB_SPIN_CAP (1u << 18)
__device__ __forceinline__ unsigned xb_ld(unsigned* p)              { return __hip_atomic_load(p, __ATOMIC_RELAXED, __HIP_MEMORY_SCOPE_AGENT); }
__device__ __forceinline__ unsigned xb_add(unsigned* p, unsigned v) { return __hip_atomic_fetch_add(p, v, __ATOMIC_RELAXED, __HIP_MEMORY_SCOPE_AGENT); }
__device__ __forceinline__ unsigned xb_xcc_id() { return (unsigned)__builtin_amdgcn_s_getreg((3 << 11) | 20) & 0xFu; }
#define XB_SPIN(cond, bar) do { unsigned _sp = 0; while (cond) { __builtin_amdgcn_s_sleep(1); \
    if ((++_sp & 255u) == 0u) { if (xb_ld(&(bar)[XB_TMO])) break; if (_sp > XB_SPIN_CAP) { atomicAdd(&(bar)[XB_TMO], 1u); break; } } } } while (0)
struct XcdBarrier { unsigned* bar; unsigned x; volatile LAS unsigned* st; int wv; };
__device__ __forceinline__ bool xb_thread0(int wv) { int l = (int)__builtin_amdgcn_mbcnt_hi(~0u, __builtin_amdgcn_mbcnt_lo(~0u, 0u)); asm volatile("" : "+v"(l)); return wv == 0 && l == 0; }
__device__ __forceinline__ XcdBarrier xcd_barrier_post(unsigned* bar, volatile LAS unsigned* st, int wv) {
    XcdBarrier b; b.bar = bar; b.x = xb_xcc_id(); b.st = st; b.wv = wv;
    if (xb_thread0(wv)) (void)xb_add(&bar[XB_XCNT(b.x)], 1u);
    return b;
}
__device__ __forceinline__ void xcd_barrier_complete(unsigned* bar, unsigned x, unsigned& nloc, unsigned& nx) {
    const unsigned G = gridDim.x * gridDim.y * gridDim.z;
    unsigned sum, cnt, mine, sp = 0u;
    for (;;) {
        sum = 0u; cnt = 0u; mine = 0u;
#pragma unroll
        for (unsigned j = 0; j < 16; ++j) { const unsigned c = xb_ld(&bar[XB_XCNT(j)]); sum += c; cnt += (c > 0u) ? 1u : 0u; mine = (j == x) ? c : mine; }
        if (sum == G) break;
        __builtin_amdgcn_s_sleep(1);
        if ((++sp & 255u) == 0u) { if (xb_ld(&bar[XB_TMO])) break; if (sp > XB_SPIN_CAP) { atomicAdd(&bar[XB_TMO], 1u); break; } }
    }
    nloc = mine > 0u ? mine : 1u; nx = cnt > 0u ? cnt : 1u;
}
__device__ __forceinline__ void xcd_barrier(const XcdBarrier& b) {
    asm volatile("s_waitcnt vmcnt(0)" ::: "memory");
    __syncthreads();
    if (xb_thread0(b.wv)) {
        unsigned* bar = b.bar;
        __builtin_amdgcn_s_waitcnt(0);
        unsigned nloc = b.st[0], nx = b.st[1];
        if (nloc == 0u) { xcd_barrier_complete(bar, b.x, nloc, nx); b.st[0] = nloc; b.st[1] = nx; }
        const unsigned old = xb_add(&bar[XB_XSUB(b.x)], 1u);
        const unsigned gen = old / nloc;
        if (old + 1u == (gen + 1u) * nloc) {
            __builtin_amdgcn_fence(__ATOMIC_RELEASE, "agent");
            asm volatile("s_waitcnt vmcnt(0)" ::: "memory");
            const unsigned og = xb_add(&bar[XB_TOP], 1u);
            const unsigned tg = og / nx;
            if (og + 1u == (tg + 1u) * nx) xb_add(&bar[XB_TOPGEN], 1u);
            else XB_SPIN(xb_ld(&bar[XB_TOPGEN]) == tg, bar);
            __builtin_amdgcn_fence(__ATOMIC_ACQUIRE, "agent");
            xb_add(&bar[XB_XGEN(b.x)], 1u);
            asm volatile("s_waitcnt vmcnt(0)" ::: "memory");
        } else {
            XB_SPIN(xb_ld(&bar[XB_XGEN(b.x)]) == gen, bar);
            __builtin_amdgcn_fence(__ATOMIC_ACQUIRE, "agent");
            asm volatile("s_waitcnt vmcnt(0)" ::: "memory");
        }
    }
    __syncthreads();
}

namespace pg8 {
constexpr int BM = 256, BK = 64, HALF = 128, HTB = HALF * BK * 2, STAGE_BYTES = 8 * HTB, NXCD = 8, WGM = 8;
__host__ __device__ __forceinline__ int lds_byte(int r, int c) { const int st = (r >> 4) * 2 + (c >> 5), rr = r & 15, cc = c & 31, ob = rr * 64 + cc * 2; return st * 1024 + (ob ^ (((ob >> 9) & 1) << 5)); }
__host__ __device__ __forceinline__ void stage_rc(int b, int& R, int& C) { const int st = b / 1024, sb = b % 1024, swz = sb ^ (((sb >> 9) & 1) << 5); R = (st >> 1) * 16 + swz / 64; C = (st & 1) * 32 + (swz % 64) / 2; }
__host__ __device__ __forceinline__ int perm32(int rho) { const int n = rho >> 4, i = rho & 15; return 8 * (i >> 2) + 4 * n + (i & 3); }

struct Unit { int pm, pn, e; };

__device__ __forceinline__ bool tile_order(int i, int G, int c, int nM, int nN, int& pm, int& pn) {
    const int nwg = nM * nN; const long L = (long)i * G + c; if (L >= nwg) return false;
    int wgid = (int)L; { const int q = nwg / NXCD, r = nwg % NXCD, xcd = wgid % NXCD, off = wgid / NXCD; wgid = (xcd < r ? xcd * (q + 1) : r * (q + 1) + (xcd - r) * q) + off; }
    const int nig = WGM * nN, gid = wgid / nig, fm = gid * WGM, gsz = (nM - fm) < WGM ? (nM - fm) : WGM;
    pm = fm + ((wgid % nig) % gsz); pn = (wgid % nig) / gsz; return true;
}
struct DenseOrder {
    int nM, nN, G, c, K; const bf16_t* Bt; int rev = 0;
    __device__ __forceinline__ bool next(int i, Unit& u) const { u.e = 0; if (!tile_order(i, G, c, nM, nN, u.pm, u.pn)) return false; if (rev) u.pm = nM - 1 - u.pm; return true; }
    static constexpr bool GATHER = false, FP8 = false; static constexpr int SC_W = 127, SC_W1 = 127, SC_A = 127;
    __device__ __forceinline__ void a_off(const Unit&, int, unsigned (&)[2][2]) const {}
    __device__ __forceinline__ const char* b_ptr(const Unit& u) const { return (const char*)Bt + (size_t)u.pn * BM * K * 2; }
};
template <bool GATHER_, bool FP8_, int SC_A_ = 127, int SC_W1_ = F8_W_SC> struct MoeOrder {
    static constexpr bool GATHER = GATHER_, FP8 = FP8_; static constexpr int SC_W = F8_W_SC, SC_W1 = SC_W1_, SC_A = SC_A_;
    int tb[NE + 1]; int cnt[NE]; int nN, G, c, K; const unsigned char* Bt; size_t bstride; const int* list; int rev = 0;
    __device__ __forceinline__ bool next(int i, Unit& u) const {
        if (!tile_order(i, G, c, tb[NE], nN, u.pm, u.pn)) return false;
        if (rev) u.pm = tb[NE] - 1 - u.pm;
        int e = 0;
#pragma unroll
        for (int k = 1; k < NE; ++k) e += (u.pm >= tb[k]) ? 1 : 0;
        u.e = e; return true;
    }
    __device__ __forceinline__ void a_off(const Unit& u, int tid, unsigned (&off)[2][2]) const {
        int R[2], C[2];
#pragma unroll
        for (int i = 0; i < 2; ++i) stage_rc(tid * 16 + i * 8192, R[i], C[i]);
        {
            int tbe = 0, ce = 0;
#pragma unroll
            for (int k = 0; k < NE; ++k) if (k == u.e) { tbe = tb[k]; ce = cnt[k]; }
            const int r0 = (u.pm - tbe) * BM; const int* lp = list + (size_t)u.e * T;
#pragma unroll
            for (int h = 0; h < 2; ++h)
#pragma unroll
                for (int i = 0; i < 2; ++i) { const int rk = r0 + h * HALF + R[i]; int tok = 0; if (rk < ce) tok = lp[rk]; off[h][i] = (unsigned)((size_t)tok * K + C[i] * 2); }
        }
    }
    __device__ __forceinline__ const char* b_ptr(const Unit& u) const { return (const char*)Bt + (size_t)u.e * bstride + (size_t)u.pn * BM * K; }
};

constexpr int SSQ_LD = 8;
struct RowSsq {
    float* ssq; LAS float* P;
    __device__ __forceinline__ void run(float (&part)[2][4], const Unit& u, int wr, int wc, int fr, int fq) const {
#pragma unroll
        for (int ai = 0; ai < 2; ++ai)
#pragma unroll
            for (int m = 0; m < 4; ++m) { float sq = part[ai][m]; sq = swap16_add(sq, sq); sq = swap32_add(sq, sq);
                if (fq == 0) P[(ai * HALF + wr * 64 + m * 16 + fr) * 4 + wc] = sq; }
        asm volatile("s_waitcnt lgkmcnt(0)" ::: "memory"); __builtin_amdgcn_s_barrier(); asm volatile("" ::: "memory");
        const int t_ = (wr * 4 + wc) * 64 + fq * 16 + fr;
        if (t_ < 256) { const f32x4 p = *(const LAS f32x4*)(P + t_ * 4); ssq[(size_t)(u.pm * BM + t_) * SSQ_LD + u.pn] = (p[0] + p[1]) + (p[2] + p[3]); }
    }
};
__device__ __forceinline__ float row_rstd(const float* ssq, int np, int row) {
    const f32x4 a = *(const f32x4*)(ssq + (size_t)row * SSQ_LD); float t = (a[0] + a[1]) + (a[2] + a[3]);
    if (np == 8) { const f32x4 b = *(const f32x4*)(ssq + (size_t)row * SSQ_LD + 4); t += (b[0] + b[1]) + (b[2] + b[3]); }
    return 1.0f / sqrtf(t * (1.0f / D) + RMS_EPS);
}
struct EpiBf16 {
    static constexpr bool PERM = true;
    bf16_t* O; int ldc; int split_cols; size_t split_stride; float scale0; const float* ssq; int np;
    __device__ __forceinline__ void operator()(const f32x4 (&acc)[2][2][4][2], const Unit& u, int wr, int wc, int fr, int fq) const {
        const int row0 = u.pm * BM + wr * 64 + fr; int colt = u.pn * BM; bf16_t* base = O;
        float sc0 = 1.f; if (split_cols) { const int t = colt / split_cols; base += (size_t)t * split_stride; colt -= t * split_cols; if (t == 0) sc0 = scale0; }
        const int col0 = colt + wc * 32 + 8 * fq;
#pragma unroll
        for (int ai = 0; ai < 2; ++ai)
#pragma unroll
            for (int m = 0; m < 4; ++m) { bf16_t* rowp = base + (size_t)(row0 + ai * HALF + m * 16) * ldc + col0;
                float sc = sc0; if (ssq) sc *= row_rstd(ssq, np, row0 + ai * HALF + m * 16);
#pragma unroll
                for (int bj = 0; bj < 2; ++bj) { const f32x4 v0 = acc[ai][bj][m][0] * sc, v1 = acc[ai][bj][m][1] * sc;
                    u32x4 w; w.x = cvt_pk_bf16(v0[0], v0[1]); w.y = cvt_pk_bf16(v0[2], v0[3]); w.z = cvt_pk_bf16(v1[0], v1[1]); w.w = cvt_pk_bf16(v1[2], v1[3]);
                    *(u32x4*)(rowp + bj * HALF) = w; } }
    }
};
struct EpiSwiGlu {
    static constexpr bool PERM = true;
    bf16_t* O; int ldc; const float* ssq; int np;
    __device__ __forceinline__ void operator()(const f32x4 (&acc)[2][2][4][2], const Unit& u, int wr, int wc, int fr, int fq) const {
        const int row0 = u.pm * BM + wr * 64 + fr; const int col0 = u.pn * HALF + wc * 32 + 8 * fq;
#pragma unroll
        for (int ai = 0; ai < 2; ++ai)
#pragma unroll
            for (int m = 0; m < 4; ++m) { bf16_t* rowp = O + (size_t)(row0 + ai * HALF + m * 16) * ldc + col0;
                float sc = 1.f; if (ssq) sc = row_rstd(ssq, np, row0 + ai * HALF + m * 16);
                float r[8];
#pragma unroll
                for (int n = 0; n < 2; ++n)
#pragma unroll
                    for (int i = 0; i < 4; ++i) { const float g = acc[ai][0][m][n][i] * sc, up = acc[ai][1][m][n][i] * sc; r[n * 4 + i] = g * sigmoidf_(g) * up; }
                u32x4 w; w.x = cvt_pk_bf16(r[0], r[1]); w.y = cvt_pk_bf16(r[2], r[3]); w.z = cvt_pk_bf16(r[4], r[5]); w.w = cvt_pk_bf16(r[6], r[7]);
                *(u32x4*)rowp = w; }
    }
};
struct EpiBf16Plain {
    static constexpr bool PERM = true;
    bf16_t* O; int ldc;
    __device__ __forceinline__ void operator()(const f32x4 (&acc)[2][2][4][2], const Unit& u, int wr, int wc, int fr, int fq) const {
        const int row0 = u.pm * BM + wr * 64 + fr; const int col0 = u.pn * BM + wc * 32 + 8 * fq;
#pragma unroll
        for (int ai = 0; ai < 2; ++ai)
#pragma unroll
            for (int m = 0; m < 4; ++m) { bf16_t* rowp = O + (size_t)(row0 + ai * HALF + m * 16) * ldc + col0;
#pragma unroll
                for (int bj = 0; bj < 2; ++bj) { const f32x4 v0 = acc[ai][bj][m][0], v1 = acc[ai][bj][m][1];
                    u32x4 w; w.x = cvt_pk_bf16(v0[0], v0[1]); w.y = cvt_pk_bf16(v0[2], v0[3]); w.z = cvt_pk_bf16(v1[0], v1[1]); w.w = cvt_pk_bf16(v1[2], v1[3]);
                    *(u32x4*)(rowp + bj * HALF) = w; } }
    }
};
struct EpiSwiGlu8 {
    static constexpr bool PERM = true;
    unsigned char* O; int ldc;
    __device__ __forceinline__ const float* ssq_src() const { return nullptr; }
    __device__ __forceinline__ void operator()(const f32x4 (&acc)[2][2][4][2], const Unit& u, int wr, int wc, int fr, int fq) const {
        const int row0 = u.pm * BM + wr * 64 + fr; const int col0 = u.pn * HALF + wc * 32 + 8 * fq;
#pragma unroll
        for (int ai = 0; ai < 2; ++ai)
#pragma unroll
            for (int m = 0; m < 4; ++m) { unsigned char* rowp = O + (size_t)(row0 + ai * HALF + m * 16) * ldc + col0;
                float r[8];
#pragma unroll
                for (int n = 0; n < 2; ++n)
#pragma unroll
                    for (int i = 0; i < 4; ++i) { const float g = acc[ai][0][m][n][i], up = acc[ai][1][m][n][i]; r[n * 4 + i] = g * up * fast_rcp(1.0f + fast_exp2(g)); }
                u32x2 w; w.x = cvt_pk_fp8x4(r[0], r[1], r[2], r[3]); w.y = cvt_pk_fp8x4(r[4], r[5], r[6], r[7]);
                *(u32x2*)rowp = w; }
    }
};
struct EpiGluRes {
    static constexpr bool PERM = true;
    bf16_t* xr; int ldc; RowSsq rs;
    __device__ __forceinline__ void operator()(const f32x4 (&acc)[2][2][4][2], const Unit& u, int wr, int wc, int fr, int fq) const {
        const int row0 = u.pm * BM + wr * 64 + fr; const int col0 = u.pn * HALF + wc * 32 + 8 * fq;
        float part[2][4]; u32x4 s[2][4];
#pragma unroll
        for (int ai = 0; ai < 2; ++ai)
#pragma unroll
            for (int m = 0; m < 4; ++m) s[ai][m] = *(const u32x4*)(xr + (size_t)(row0 + ai * HALF + m * 16) * ldc + col0);
#pragma unroll
        for (int ai = 0; ai < 2; ++ai)
#pragma unroll
            for (int m = 0; m < 4; ++m) { float o[8]; float sq = 0.f;
#pragma unroll
                for (int n = 0; n < 2; ++n)
#pragma unroll
                    for (int i = 0; i < 4; ++i) { const int k = n * 4 + i; const unsigned wd = s[ai][m][k >> 1]; const float sv = (k & 1) ? __uint_as_float(wd & 0xffff0000u) : __uint_as_float(wd << 16);
                        o[k] = sv + acc[ai][0][m][n][i] * sigmoidf_(acc[ai][1][m][n][i]); sq += o[k] * o[k]; }
                u32x4 w; w.x = cvt_pk_bf16(o[0], o[1]); w.y = cvt_pk_bf16(o[2], o[3]); w.z = cvt_pk_bf16(o[4], o[5]); w.w = cvt_pk_bf16(o[6], o[7]);
                *(u32x4*)(xr + (size_t)(row0 + ai * HALF + m * 16) * ldc + col0) = w; part[ai][m] = sq; }
        rs.run(part, u, wr, wc, fr, fq);
    }
};
template <bool STATS> struct EpiResAdd {
    static constexpr bool PERM = true;
    bf16_t* xr; int ldc; RowSsq rs;
    __device__ __forceinline__ void operator()(const f32x4 (&acc)[2][2][4][2], const Unit& u, int wr, int wc, int fr, int fq) const {
        const int row0 = u.pm * BM + wr * 64 + fr; const int col0 = u.pn * BM + wc * 32 + 8 * fq;
        float part[2][4];
#pragma unroll
        for (int ai = 0; ai < 2; ++ai) { u32x4 s[4][2];
#pragma unroll
            for (int m = 0; m < 4; ++m)
#pragma unroll
                for (int bj = 0; bj < 2; ++bj) s[m][bj] = *(const u32x4*)(xr + (size_t)(row0 + ai * HALF + m * 16) * ldc + col0 + bj * HALF);
#pragma unroll
            for (int m = 0; m < 4; ++m) { float sq = 0.f;
#pragma unroll
                for (int bj = 0; bj < 2; ++bj) { float o[8];
#pragma unroll
                    for (int n = 0; n < 2; ++n)
#pragma unroll
                        for (int i = 0; i < 4; ++i) { const int k = n * 4 + i; const unsigned wd = s[m][bj][k >> 1]; const float sv = (k & 1) ? __uint_as_float(wd & 0xffff0000u) : __uint_as_float(wd << 16);
                            o[k] = sv + acc[ai][bj][m][n][i]; if (STATS) sq += o[k] * o[k]; }
                    u32x4 w; w.x = cvt_pk_bf16(o[0], o[1]); w.y = cvt_pk_bf16(o[2], o[3]); w.z = cvt_pk_bf16(o[4], o[5]); w.w = cvt_pk_bf16(o[6], o[7]);
                    *(u32x4*)(xr + (size_t)(row0 + ai * HALF + m * 16) * ldc + col0 + bj * HALF) = w; }
                part[ai][m] = sq; } }
        if (STATS) rs.run(part, u, wr, wc, fr, fq);
    }
};

template <class Epi, class Sched>
__device__ __forceinline__ void gemm_phase(const int wv, LAS unsigned char* lds, const void* Abase, const int Kelems, const Sched& S, const Epi& E) {
    constexpr bool GATHER = Sched::GATHER, FP8 = Sched::FP8;
    const int tid = opaque_tid(wv), wid = wv, lane = tid & 63, wr = wid >> 2, wc = wid & 3, fr = lane & 15, fq = lane >> 4;
    const int K = FP8 ? (Kelems >> 1) : Kelems;
    const int nt = K / BK;
    unsigned voffA[2], voffB[2];
#pragma unroll
    for (int i = 0; i < 2; ++i) { int R, C; stage_rc(tid * 16 + i * 8192, R, C); const int Rb = Epi::PERM ? ((R & ~31) + perm32(R & 31)) : R;
        voffA[i] = (unsigned)(R * K + C) * 2u; voffB[i] = (unsigned)(Rb * K + C) * 2u; }
    LAS u32x4* const offn_lds = (LAS u32x4*)(lds + STAGE_BYTES + 4096) + tid;
    const size_t kstep = (size_t)(BK * 2);
    const size_t hstep = (size_t)HALF * K * 2;
    const size_t tstep = 2 * hstep;
    const unsigned ldsw = (unsigned)wid * 1024u;
    const int aoff = lds_byte(wr * 64 + fr, fq * 8), boff = lds_byte(wc * 32 + fr, fq * 8);
#define PG8_SA(b, h) (((b) * 2 + (h)) * HTB)
#define PG8_SB(b, h) ((4 + (b) * 2 + (h)) * HTB)
#define PG8_STAGE(bufoff, gbase, voff) do { _Pragma("unroll") for (int _i = 0; _i < 2; ++_i) \
        __builtin_amdgcn_global_load_lds((const unsigned*)((const char*)(gbase) + (voff)[_i]), (LAS unsigned*)(lds + (bufoff) + ldsw + _i * 8192), 16, 0, 0); } while (0)
#define PG8_STAGE_A(bufoff, h, base, og) do { if constexpr (GATHER) { PG8_STAGE(bufoff, base, og); } else { PG8_STAGE(bufoff, (base) + ((h) ? hstep : 0), voffA); } } while (0)
#define PG8_LD8(d8, addr) do { const i32x4 lo_ = *(const LAS i32x4*)(addr), hi_ = *(const LAS i32x4*)((addr) + 1024); \
        d8[0] = lo_[0]; d8[1] = lo_[1]; d8[2] = lo_[2]; d8[3] = lo_[3]; d8[4] = hi_[0]; d8[5] = hi_[1]; d8[6] = hi_[2]; d8[7] = hi_[3]; } while (0)
#define PG8_LDA(dst, b, h) do { if constexpr (FP8) { _Pragma("unroll") for (int m = 0; m < 4; ++m) PG8_LD8(dst##8[m], lds + PG8_SA(b, h) + aoff + m * 2048); } \
        else { _Pragma("unroll") for (int m = 0; m < 4; ++m) _Pragma("unroll") for (int k = 0; k < 2; ++k) dst[m][k] = *(const LAS bf16x8*)(lds + PG8_SA(b, h) + aoff + m * 2048 + k * 1024); } } while (0)
#define PG8_LDB(dst, b, h) do { if constexpr (FP8) { _Pragma("unroll") for (int n = 0; n < 2; ++n) PG8_LD8(dst##8[n], lds + PG8_SB(b, h) + boff + n * 2048); } \
        else { _Pragma("unroll") for (int n = 0; n < 2; ++n) _Pragma("unroll") for (int k = 0; k < 2; ++k) dst[n][k] = *(const LAS bf16x8*)(lds + PG8_SB(b, h) + boff + n * 2048 + k * 1024); } } while (0)
#define PG8_CAT8(x) __builtin_shufflevector(__builtin_bit_cast(i32x4, (x)[0]), __builtin_bit_cast(i32x4, (x)[1]), 0, 1, 2, 3, 4, 5, 6, 7)
#define PG8_MMA(ai, bj, At, Bt) do { __builtin_amdgcn_s_setprio(1); _Pragma("unroll") for (int m = 0; m < 4; ++m) _Pragma("unroll") for (int n = 0; n < 2; ++n) { \
        if constexpr (FP8) { asm volatile("v_mfma_scale_f32_16x16x128_f8f6f4 %0, %1, %2, %0, %3, %4 op_sel_hi:[0,0,0]" : "+v"(acc[ai][bj][m][n]) : "v"(Bt##8[n]), "v"(At##8[m]), "v"((bj) ? sc_w1_ : sc_w_), "v"(sc_a_)); }     \
        else { _Pragma("unroll") for (int k = 0; k < 2; ++k) acc[ai][bj][m][n] = __builtin_amdgcn_mfma_f32_16x16x32_bf16(Bt[n][k], At[m][k], acc[ai][bj][m][n], 0, 0, 0); } } \
        __builtin_amdgcn_s_setprio(0); } while (0)
#define PG8_WAIT_V(n) asm volatile("s_waitcnt vmcnt(" #n ")" ::: "memory")
#define PG8_WAIT_L(n) asm volatile("s_waitcnt lgkmcnt(" #n ")" ::: "memory")
#define PG8_BAR __builtin_amdgcn_s_barrier()
#define PG8_SCHED __builtin_amdgcn_sched_barrier(0)
    Unit cur, nxt; int ui = 0;
    if (!S.next(0, cur)) return;
    f32x4 acc[2][2][4][2];
#pragma unroll
    for (int a = 0; a < 2; ++a)
#pragma unroll
        for (int b = 0; b < 2; ++b)
#pragma unroll
            for (int m = 0; m < 4; ++m)
#pragma unroll
                for (int n = 0; n < 2; ++n) acc[a][b][m][n] = (f32x4){0.f, 0.f, 0.f, 0.f};
    const int sc_w_ = Sched::SC_W, sc_w1_ = Sched::SC_W1, sc_a_ = Sched::SC_A; (void)sc_w_; (void)sc_w1_; (void)sc_a_;
    bf16x8 At[4][2], B0[2][2], B1[2][2]; i32x8 At8[4], B08[2], B18[2];
    unsigned offC[2][2];
    if constexpr (GATHER) {
        S.a_off(cur, tid, offC);
        asm volatile("s_waitcnt vmcnt(0)" : "+v"(offC[0][0]), "+v"(offC[0][1]), "+v"(offC[1][0]), "+v"(offC[1][1]) :: "memory");
    }
    const char* cA = GATHER ? (const char*)Abase : (const char*)Abase + (size_t)cur.pm * tstep;
    const char* cB = S.b_ptr(cur);
    PG8_STAGE(PG8_SB(0, 0), cB, voffB); PG8_STAGE(PG8_SB(0, 1), cB + hstep, voffB); PG8_STAGE_A(PG8_SA(0, 0), 0, cA, offC[0]); PG8_STAGE_A(PG8_SA(0, 1), 1, cA, offC[1]);
    if (wr == 1) PG8_BAR;
    PG8_WAIT_V(2); PG8_BAR;
    PG8_STAGE(PG8_SB(1, 0), cB + kstep, voffB); PG8_STAGE_A(PG8_SA(1, 0), 0, cA + kstep, offC[0]); PG8_STAGE(PG8_SB(1, 1), cB + hstep + kstep, voffB);
    PG8_WAIT_V(6); PG8_BAR;
    for (;;) {
        const bool has_next = S.next(ui + 1, nxt);
        const char* nB = cB; const char* nA = cA;
        if (has_next) { nB = S.b_ptr(nxt); if constexpr (!GATHER) nA = (const char*)Abase + (size_t)nxt.pm * tstep; }
        if constexpr (GATHER) {
            unsigned offN[2][2];
            if (has_next) S.a_off(nxt, tid, offN);
            else {
#pragma unroll
                for (int h = 0; h < 2; ++h)
#pragma unroll
                    for (int i = 0; i < 2; ++i) offN[h][i] = offC[h][i]; }
            asm volatile("s_waitcnt vmcnt(0)" : "+v"(offN[0][0]), "+v"(offN[0][1]), "+v"(offN[1][0]), "+v"(offN[1][1]) :: "memory");
            *offn_lds = (u32x4){offN[0][0], offN[0][1], offN[1][0], offN[1][1]};
        }
#pragma unroll 1
        for (int t = 0; t < nt; t += 2) {
            const bool last = (t == nt - 2);
            const char* a1 = cA + (size_t)(t + 1) * kstep;
            const char* a2 = last ? nA : cA + (size_t)(t + 2) * kstep; const char* b2 = last ? nB : cB + (size_t)(t + 2) * kstep;
            const char* a3 = a2 + kstep; const char* b3 = b2 + kstep;
            PG8_LDB(B0, 0, 0); PG8_LDB(B1, 0, 1); PG8_SCHED; PG8_LDA(At, 0, 0); PG8_STAGE_A(PG8_SA(1, 1), 1, a1, offC[1]);
            if constexpr (GATHER) { if (last) { const u32x4 q_ = *offn_lds; offC[0][0] = q_[0]; offC[0][1] = q_[1]; offC[1][0] = q_[2]; offC[1][1] = q_[3]; } }
            PG8_WAIT_V(8); PG8_WAIT_L(0); PG8_BAR; PG8_MMA(0, 0, At, B0); PG8_MMA(0, 1, At, B1); PG8_BAR; PG8_SCHED;
            PG8_LDA(At, 0, 1); PG8_STAGE(PG8_SB(0, 0), b2, voffB); PG8_STAGE(PG8_SB(0, 1), b2 + hstep, voffB); PG8_STAGE_A(PG8_SA(0, 0), 0, a2, offC[0]);
            PG8_WAIT_V(8); PG8_WAIT_L(0); PG8_BAR; PG8_MMA(1, 0, At, B0); PG8_MMA(1, 1, At, B1); PG8_BAR; PG8_SCHED;
            PG8_LDB(B0, 1, 0); PG8_LDB(B1, 1, 1); PG8_SCHED; PG8_LDA(At, 1, 0); PG8_STAGE_A(PG8_SA(0, 1), 1, a2, offC[1]);
            PG8_WAIT_V(8); PG8_WAIT_L(0); PG8_BAR; PG8_MMA(0, 0, At, B0); PG8_MMA(0, 1, At, B1); PG8_BAR; PG8_SCHED;
            PG8_LDA(At, 1, 1); PG8_STAGE(PG8_SB(1, 0), b3, voffB); PG8_STAGE(PG8_SB(1, 1), b3 + hstep, voffB); PG8_STAGE_A(PG8_SA(1, 0), 0, a3, offC[0]);
            PG8_WAIT_V(8); PG8_WAIT_L(0); PG8_BAR; PG8_MMA(1, 0, At, B0); PG8_MMA(1, 1, At, B1); PG8_BAR; PG8_SCHED;
        }
        if (wr == 0) PG8_BAR;
        if constexpr (FP8) asm volatile("s_nop 15\n\ts_nop 15" ::: "memory");
        E(acc, cur, wr, wc, fr, fq);
        if (!has_next) break;
#pragma unroll
        for (int a = 0; a < 2; ++a)
#pragma unroll
            for (int b = 0; b < 2; ++b)
#pragma unroll
                for (int m = 0; m < 4; ++m)
#pragma unroll
                    for (int n = 0; n < 2; ++n) acc[a][b][m][n] = (f32x4){0.f, 0.f, 0.f, 0.f};
        cur = nxt; cB = nB; cA = nA; ++ui;
        if (wr == 1) PG8_BAR;
    }
    PG8_WAIT_V(0);
    PG8_BAR;
#undef PG8_SA
#undef PG8_SB
#undef PG8_STAGE
#undef PG8_STAGE_A
#undef PG8_LDA
#undef PG8_LD8
#undef PG8_LDB
#undef PG8_MMA
#undef PG8_CAT8
#undef PG8_WAIT_V
#undef PG8_WAIT_L
#undef PG8_BAR
#undef PG8_SCHED
}
}

namespace att {
constexpr int PITCH = 1024, OPITCH = 2048;
constexpr int KSLOT = 8192, VSLOT = 16384, NSLOT = 3;
constexpr int LDS_K = 0, LDS_V = NSLOT * KSLOT, LDS_WS = LDS_V + NSLOT * VSLOT, LDS_TAB = LDS_WS + 2048, LDS_OST = LDS_TAB + 512, LDS_SUB = LDS_OST + 8 * 8192, LDS_TOTAL = LDS_SUB + 1024;
static_assert(LDS_TOTAL <= RING_BYTES, "attention LDS");
__device__ __forceinline__ int crow(int r, int hi) { return (r & 3) + 8 * (r >> 2) + 4 * hi; }
__device__ __forceinline__ void glds16(const void* gsrc, unsigned lds_dst) { unsigned keep;
    asm volatile("s_mov_b32 %0, m0\n\ts_mov_b32 m0, %2\n\ts_nop 0\n\tglobal_load_lds_dwordx4 %1, off\n\ts_mov_b32 m0, %0" : "=&s"(keep) : "v"(gsrc), "s"(lds_dst) : "memory"); }
typedef LAS const char* lds_cptr;
typedef short v4i16_t __attribute__((ext_vector_type(4)));
__device__ __forceinline__ s16x4 vtr(lds_cptr p) { return __builtin_bit_cast(s16x4, __builtin_amdgcn_ds_read_tr16_b64_v4i16((LAS v4i16_t*)p)); }
#define ATT_WAIT_BAR(N) asm volatile("s_waitcnt vmcnt(" #N ") lgkmcnt(0)\n\ts_barrier" ::: "memory")

typedef __bf16 bf16x2_t __attribute__((ext_vector_type(2)));
__device__ __forceinline__ unsigned cvtpk_s(float lo, float hi) { f32x2 v = {lo, hi}; bf16x2_t b = __builtin_convertvector(v, bf16x2_t); return __builtin_bit_cast(unsigned, b); }
#define ATT_SBAR() __builtin_amdgcn_sched_barrier(0)
#define ATT_PIN(x) asm volatile("" : "+v"(x))
#define ATT_MFMA(a, b, c) __builtin_amdgcn_mfma_f32_32x32x16_bf16(a, b, c, 0, 0, 0)
__device__ __forceinline__ void attn_unit(const int wv, const int b, const int vh, const int qb, const bf16_t* Q, const bf16_t* __restrict__ Kt, const bf16_t* __restrict__ Vt, bf16_t* Y, const float* rel_bias, char* shm) {
    const int tid = opaque_tid(wv), lane = tid & 63, r32 = lane & 31, hi = lane >> 5; const int wid = wv;
    const long rowbase = (long)b * SEQ; const int q0 = qb * 256;
    const unsigned lds0 = (unsigned)(uintptr_t)shm;
    LAS float* wsf = (LAS float*)((LAS char*)shm + LDS_WS) + wid * 64;
    LAS float* tab = (LAS float*)((LAS char*)shm + LDS_TAB);
    if (tid < 128) { const int d = tid; int bk = d;
        if (d >= 16) { bk = 16 + (int)(__logf((float)d * (1.0f / 16.0f)) / 2.0794415416798357f * 16.0f); bk = bk > 31 ? 31 : bk; }
        const int h = vh >> 1; tab[d] = (rel_bias[bk * 8 + h] - rel_bias[31 * 8 + h]) * LOG2E; }
    const bf16_t* Qw = Q + (rowbase + q0 + wid * 32) * PITCH + vh * 64;
    const bf16_t* Kh = Kt + rowbase * PITCH + vh * 64; const bf16_t* Vh = Vt + rowbase * PITCH + (vh >> 1) * 128;
    bf16x8 qr[4];
#pragma unroll
    for (int d0 = 0; d0 < 4; ++d0) qr[d0] = *reinterpret_cast<const bf16x8*>(&Qw[(long)r32 * PITCH + d0 * 16 + hi * 8]);
    asm volatile("s_waitcnt vmcnt(0)" : "+v"(qr[0]), "+v"(qr[1]), "+v"(qr[2]), "+v"(qr[3]) :: "memory");
    const bf16_t* ksrc = Kh + (long)lane * PITCH + wid * 8;
    const bf16_t* vsrc = Vh + (long)(16 * (wid & 3) + (lane >> 2)) * PITCH + (wid >> 2) * 32 + (lane & 3) * 8;
    const unsigned kdst = lds0 + LDS_K + wid * 1024, vdst = lds0 + LDS_V + wid * 1024;
#define ATT_DMA_K(t, sl) glds16(ksrc + (long)(t) * 64 * PITCH, (unsigned)__builtin_amdgcn_readfirstlane(kdst + (sl) * KSLOT))
#define ATT_DMA_V(t, sl) do { glds16(vsrc + (long)(t) * 64 * PITCH, (unsigned)__builtin_amdgcn_readfirstlane(vdst + (sl) * VSLOT)); \
        glds16(vsrc + (long)(t) * 64 * PITCH + 64, (unsigned)__builtin_amdgcn_readfirstlane(vdst + (sl) * VSLOT + 8192)); } while (0)
    const int NT = 4 * qb + 4;
    ATT_DMA_K(0, 0); ATT_DMA_K(1, 1); ATT_DMA_V(0, 0);
    const lds_cptr shm3 = (lds_cptr)shm;
    const lds_cptr kp0 = shm3 + LDS_K + hi * 1024 + r32 * 16;
    const lds_cptr vp0 = shm3 + LDS_V + ((lane >> 4) & 1) * 32 + (lane & 3) * 8 + (4 * hi + ((lane & 15) >> 2)) * 64;
    f32x16 o[4];
#pragma unroll
    for (int i = 0; i < 4; ++i) o[i] = f32x16{};
    float mhat = 0.f, l_reg = 0.f; f32x16 negm = f32x16{}; asm volatile("" : "+v"(negm));
    const int qpos = q0 + wid * 32 + r32; const int qfirst_w = q0 + wid * 32;
    bool resc = false;
    int s_prev = 0, s_cur = 0, s_next = 1;
#define ATT_ROT() do { s_prev = s_cur; s_cur = s_next; s_next = (s_next == 2) ? 0 : s_next + 1; } while (0)
#define ATT_CMASK(P0, P1, t) do { if (64 * (t) + 176 > qfirst_w) {     \
        const int kb_ = 64 * (t) + 4 * hi; \
        _Pragma("unroll") for (int r8 = 0; r8 < 16; r8 += 4) { float bb0_[4], bb1_[4]; \
            _Pragma("unroll") for (int r = r8; r < r8 + 4; ++r) { const int d0_ = qpos - (kb_ + (r & 3) + 8 * (r >> 2)), d1_ = d0_ - 32; \
                bb0_[r - r8] = tab[min(max(d0_, 0), 127)]; bb1_[r - r8] = tab[min(max(d1_, 0), 127)]; } \
            _Pragma("unroll") for (int r = r8; r < r8 + 4; ++r) { const int d0_ = qpos - (kb_ + (r & 3) + 8 * (r >> 2)), d1_ = d0_ - 32; \
                const float x0_ = P0[r] + bb0_[r - r8], x1_ = P1[r] + bb1_[r - r8];     \
                P0[r] = d0_ < 0 ? -INFINITY : x0_; P1[r] = d1_ < 0 ? -INFINITY : x1_; } } } } while (0)
#define ATT_ROWMAX(rm, P0, P1) do { float a_ = fmaxf(fmaxf(P0[0], P0[1]), P1[0]), b_ = fmaxf(fmaxf(P0[2], P0[3]), P1[1]); a_ = fmaxf(fmaxf(a_, P1[2]), P1[3]); \
        _Pragma("unroll") for (int r = 4; r < 16; r += 4) { a_ = fmaxf(fmaxf(a_, P0[r]), P0[r + 1]); b_ = fmaxf(fmaxf(b_, P0[r + 2]), P0[r + 3]); a_ = fmaxf(fmaxf(a_, P1[r]), P1[r + 1]); b_ = fmaxf(fmaxf(b_, P1[r + 2]), P1[r + 3]); } \
        rm = fmaxf(a_, b_); { auto rr_ = __builtin_amdgcn_permlane32_swap(__float_as_uint(rm), __float_as_uint(rm), false, false); rm = fmaxf(__uint_as_float(rr_[0]), __uint_as_float(rr_[1])); } } while (0)
#define ATT_RESC() do { if (resc) { _Pragma("unroll") for (int r = 0; r < 16; ++r) { const float f_ = wsf[crow(r, hi)]; _Pragma("unroll") for (int d_ = 0; d_ < 4; ++d_) o[d_][r] *= f_; } } } while (0)
    f32x16 pA0, pA1, pB0, pB1;
    u32x4 pw0, pw1, pw2, pw3;
    bf16x8 kfr[8]; s16x4 vlo[16], vhh[16];
#define ATT_KRD(i) do { kfr[i] = *(const LAS bf16x8*)(kp_ + ((i) >> 1) * 2048 + ((i) & 1) * 512); } while (0)
#define ATT_VRD(j) do { vlo[j] = vtr(vp_ + ((j) & 3) * 4096 + ((j) >> 2) * 1024); vhh[j] = vtr(vp_ + ((j) & 3) * 4096 + ((j) >> 2) * 1024 + 512); } while (0)
#define ATT_VFR(j) (bf16x8){vlo[j][0], vlo[j][1], vlo[j][2], vlo[j][3], vhh[j][0], vhh[j][1], vhh[j][2], vhh[j][3]}
    ATT_WAIT_BAR(3);
    ATT_DMA_K(2, 2); ATT_DMA_V(1, 1);
    { const lds_cptr kp_ = kp0;
#pragma unroll
      for (int i = 0; i < 8; ++i) ATT_KRD(i);
#pragma unroll
      for (int d0 = 0; d0 < 4; ++d0) { pA0 = ATT_MFMA(kfr[2 * d0], qr[d0], d0 == 0 ? negm : pA0); pA1 = ATT_MFMA(kfr[2 * d0 + 1], qr[d0], d0 == 0 ? negm : pA1); } }
    ATT_CMASK(pA0, pA1, 0);
    { float rm; ATT_ROWMAX(rm, pA0, pA1); mhat = rm;
#pragma unroll
      for (int r = 0; r < 16; ++r) { pA0[r] -= rm; pA1[r] -= rm; }
#pragma unroll
      for (int r = 0; r < 16; ++r) negm[r] = -mhat;
      asm volatile("" : "+v"(negm));
#pragma unroll
      for (int r = 0; r < 16; ++r) { pA0[r] = fast_exp2(pA0[r]); pA1[r] = fast_exp2(pA1[r]); } }
    ATT_WAIT_BAR(3);
    ATT_ROT();
#define ATT_PKW(P, B) cvtpk_s(P[B], P[(B) + 1])
#define ATT_PAF(k) __builtin_bit_cast(bf16x8, pw##k)
#define ATT_GAPA(i, C, INIT, A0, A1, A2, A3, W0, W1, PW) do { if ((i) + 3 < 8) ATT_KRD((i) + 3); if (DEEP_ && (i) >= 2) ATT_VRD((i) - 2); \
        C = ATT_MFMA(kfr[i], qr[(i) >> 1], INIT); sacc += A0; sacc += A1; sacc += A2; sacc += A3; ATT_PIN(sacc); W0; W1; ATT_PIN(PW); ATT_SBAR(); } while (0)
#define ATT_GAPB(j, KS, X, B) do { if ((j) + 6 < 16) ATT_VRD((j) + 6); o[(j) & 3] = ATT_MFMA(ATT_PAF(KS), ATT_VFR(j), o[(j) & 3]); \
        X[B] = fast_exp2(X[B]); X[(B) + 1] = fast_exp2(X[(B) + 1]); ATT_PIN(X); ATT_SBAR(); } while (0)
#define ATT_STEP(C0, C1, P0, P1, t, GK, GV, THR, DEEP) do { ATT_SBAR(); constexpr bool DEEP_ = (DEEP); \
        if (GK) ATT_DMA_K((t) + 2, s_prev); if (GV) ATT_DMA_V((t) + 1, s_next); \
        const lds_cptr kp_ = kp0 + s_cur * KSLOT; const lds_cptr vp_ = vp0 + s_prev * VSLOT; \
        ATT_KRD(0); ATT_KRD(1); ATT_KRD(2); ATT_SBAR(); float sacc = P0[0] + P0[1]; \
        ATT_GAPA(0, C0, negm, P0[2], P0[3], P0[4], P0[5],     pw0[0] = ATT_PKW(P0, 0),  pw0[1] = ATT_PKW(P0, 2),  pw0); \
        ATT_GAPA(1, C1, negm, P0[6], P0[7], P0[8], P0[9],     pw0[2] = ATT_PKW(P0, 4),  pw0[3] = ATT_PKW(P0, 6),  pw0); \
        ATT_GAPA(2, C0, C0,   P0[10], P0[11], P0[12], P0[13], pw1[0] = ATT_PKW(P0, 8),  pw1[1] = ATT_PKW(P0, 10), pw1); \
        ATT_GAPA(3, C1, C1,   P0[14], P0[15], P1[0], P1[1],   pw1[2] = ATT_PKW(P0, 12), pw1[3] = ATT_PKW(P0, 14), pw1); \
        ATT_GAPA(4, C0, C0,   P1[2], P1[3], P1[4], P1[5],     pw2[0] = ATT_PKW(P1, 0),  pw2[1] = ATT_PKW(P1, 2),  pw2); \
        ATT_GAPA(5, C1, C1,   P1[6], P1[7], P1[8], P1[9],     pw2[2] = ATT_PKW(P1, 4),  pw2[3] = ATT_PKW(P1, 6),  pw2); \
        ATT_GAPA(6, C0, C0,   P1[10], P1[11], P1[12], P1[13], pw3[0] = ATT_PKW(P1, 8),  pw3[1] = ATT_PKW(P1, 10), pw3); \
        ATT_GAPA(7, C1, C1,   P1[14], P1[15], 0.f, 0.f,       pw3[2] = ATT_PKW(P1, 12), pw3[3] = ATT_PKW(P1, 14), pw3); \
        l_reg += sacc; \
        ATT_CMASK(C0, C1, t); \
          \
          \
        { float rs_ = sacc; { auto rr_ = __builtin_amdgcn_permlane32_swap(__float_as_uint(rs_), __float_as_uint(rs_), false, false); rs_ = __uint_as_float(rr_[0]) + __uint_as_float(rr_[1]); } resc = false; \
          if (__builtin_expect(__any(rs_ > (float)(64 << (THR))), 0)) { const float dl = fmaxf(__builtin_amdgcn_logf(rs_) - 6.0f, 0.f); mhat += dl; \
            _Pragma("unroll") for (int r = 0; r < 16; ++r) { C0[r] -= dl; C1[r] -= dl; } \
            _Pragma("unroll") for (int r = 0; r < 16; ++r) negm[r] = -mhat; asm volatile("" : "+v"(negm)); \
            const float f = fast_exp2(-dl); l_reg *= f; if (hi == 0) wsf[r32] = f; resc = true; } } \
        ATT_SBAR(); \
        if (!DEEP_) { ATT_VRD(0); ATT_VRD(1); ATT_VRD(2); ATT_VRD(3); ATT_VRD(4); ATT_VRD(5); ATT_SBAR(); }     \
        ATT_GAPB(0, 0, C0, 0);   ATT_GAPB(1, 0, C0, 2);   ATT_GAPB(2, 0, C0, 4);   ATT_GAPB(3, 0, C0, 6); \
        ATT_GAPB(4, 1, C0, 8);   ATT_GAPB(5, 1, C0, 10);  ATT_GAPB(6, 1, C0, 12);  ATT_GAPB(7, 1, C0, 14); \
        ATT_GAPB(8, 2, C1, 0);   ATT_GAPB(9, 2, C1, 2);   ATT_GAPB(10, 2, C1, 4);  ATT_GAPB(11, 2, C1, 6); \
        ATT_GAPB(12, 3, C1, 8);  ATT_GAPB(13, 3, C1, 10); ATT_GAPB(14, 3, C1, 12); ATT_GAPB(15, 3, C1, 14); \
    } while (0)
    int t = 1;
#undef ATT_CMASK
#define ATT_CMASK(P0, P1, t) do { } while (0)
    for (; t + 7 < NT; t += 2) {
        ATT_STEP(pB0, pB1, pA0, pA1, t, true, true, 8, true);     ATT_WAIT_BAR(3); ATT_RESC(); ATT_ROT();
        ATT_STEP(pA0, pA1, pB0, pB1, t + 1, true, true, 8, true); ATT_WAIT_BAR(3); ATT_RESC(); ATT_ROT();
    }
#undef ATT_CMASK
#define ATT_CMASK(P0, P1, t) do { if (64 * (t) + 176 > qfirst_w) {     \
        const int kb_ = 64 * (t) + 4 * hi; \
        _Pragma("unroll") for (int r8 = 0; r8 < 16; r8 += 4) { float bb0_[4], bb1_[4]; \
            _Pragma("unroll") for (int r = r8; r < r8 + 4; ++r) { const int d0_ = qpos - (kb_ + (r & 3) + 8 * (r >> 2)), d1_ = d0_ - 32; \
                bb0_[r - r8] = tab[min(max(d0_, 0), 127)]; bb1_[r - r8] = tab[min(max(d1_, 0), 127)]; } \
            _Pragma("unroll") for (int r = r8; r < r8 + 4; ++r) { const int d0_ = qpos - (kb_ + (r & 3) + 8 * (r >> 2)), d1_ = d0_ - 32; \
                const float x0_ = P0[r] + bb0_[r - r8], x1_ = P1[r] + bb1_[r - r8];     \
                P0[r] = d0_ < 0 ? -INFINITY : x0_; P1[r] = d1_ < 0 ? -INFINITY : x1_; } } } } while (0)
#define ATT_ENDW(tt) do { if ((tt) + 2 < NT) { ATT_WAIT_BAR(3); } else { ATT_WAIT_BAR(0); } } while (0)
    for (; t + 1 < NT; t += 2) {
        ATT_STEP(pB0, pB1, pA0, pA1, t, (t + 2 < NT), (t + 1 < NT), 8, false);         ATT_ENDW(t);     ATT_RESC(); ATT_ROT();
        ATT_STEP(pA0, pA1, pB0, pB1, t + 1, (t + 3 < NT), (t + 2 < NT), 8, false);     ATT_ENDW(t + 1); ATT_RESC(); ATT_ROT();
    }
    ATT_STEP(pB0, pB1, pA0, pA1, NT - 1, false, false, 8, false); ATT_RESC();
    { float sacc = pB0[0] + pB0[1];
#pragma unroll
      for (int r = 2; r < 16; ++r) sacc += pB0[r];
#pragma unroll
      for (int r = 0; r < 16; ++r) sacc += pB1[r];
      l_reg += sacc;
      pw0 = (u32x4){ATT_PKW(pB0, 0), ATT_PKW(pB0, 2), ATT_PKW(pB0, 4), ATT_PKW(pB0, 6)}; pw1 = (u32x4){ATT_PKW(pB0, 8), ATT_PKW(pB0, 10), ATT_PKW(pB0, 12), ATT_PKW(pB0, 14)};
      pw2 = (u32x4){ATT_PKW(pB1, 0), ATT_PKW(pB1, 2), ATT_PKW(pB1, 4), ATT_PKW(pB1, 6)}; pw3 = (u32x4){ATT_PKW(pB1, 8), ATT_PKW(pB1, 10), ATT_PKW(pB1, 12), ATT_PKW(pB1, 14)};
      const lds_cptr vp_ = vp0 + s_cur * VSLOT;
#pragma unroll
      for (int d0 = 0; d0 < 4; ++d0) {
          const s16x4 l0 = vtr(vp_ + d0 * 4096), h0 = vtr(vp_ + d0 * 4096 + 512), l1 = vtr(vp_ + d0 * 4096 + 1024), h1 = vtr(vp_ + d0 * 4096 + 1536);
          const s16x4 l2 = vtr(vp_ + d0 * 4096 + 2048), h2 = vtr(vp_ + d0 * 4096 + 2560), l3 = vtr(vp_ + d0 * 4096 + 3072), h3 = vtr(vp_ + d0 * 4096 + 3584);
          o[d0] = ATT_MFMA(ATT_PAF(0), ((bf16x8){l0[0], l0[1], l0[2], l0[3], h0[0], h0[1], h0[2], h0[3]}), o[d0]);
          o[d0] = ATT_MFMA(ATT_PAF(1), ((bf16x8){l1[0], l1[1], l1[2], l1[3], h1[0], h1[1], h1[2], h1[3]}), o[d0]);
          o[d0] = ATT_MFMA(ATT_PAF(2), ((bf16x8){l2[0], l2[1], l2[2], l2[3], h2[0], h2[1], h2[2], h2[3]}), o[d0]);
          o[d0] = ATT_MFMA(ATT_PAF(3), ((bf16x8){l3[0], l3[1], l3[2], l3[3], h3[0], h3[1], h3[2], h3[3]}), o[d0]);
      } }
    { auto rr = __builtin_amdgcn_permlane32_swap(__float_as_uint(l_reg), __float_as_uint(l_reg), false, false); l_reg = __uint_as_float(rr[0]) + __uint_as_float(rr[1]); }
    if (hi == 0) wsf[32 + r32] = l_reg;
    { LAS bf16_t* stg = (LAS bf16_t*)((LAS char*)shm + LDS_OST) + wid * 4096;
      if ((vh & 1) == 0) {
#pragma unroll
          for (int r = 0; r < 16; ++r) { const int orow = crow(r, hi); const float rl = fast_rcp(wsf[32 + orow]);
#pragma unroll
              for (int d0 = 0; d0 < 4; ++d0) stg[orow * 128 + d0 * 32 + r32] = (bf16_t)cvtpk_s(o[d0][r] * rl, 0.f); }
          asm volatile("s_waitcnt lgkmcnt(0)" ::: "memory");
      } else {
          LAS const float* sub = (LAS const float*)((LAS char*)shm + LDS_SUB);
          const float lam = sub[128];
#pragma unroll
          for (int r = 0; r < 16; ++r) { const int orow = crow(r, hi); const float rl = fast_rcp(wsf[32 + orow]) * lam;
#pragma unroll
              for (int d0 = 0; d0 < 4; ++d0) { LAS bf16_t* p = stg + orow * 128 + d0 * 32 + r32; const float o1 = __uint_as_float(((unsigned)*p) << 16); *p = (bf16_t)cvtpk_s(o1 - o[d0][r] * rl, 0.f); } }
          asm volatile("s_waitcnt lgkmcnt(0)" ::: "memory");
          bf16_t* Yw = Y + (rowbase + q0 + wid * 32) * PITCH + (vh >> 1) * 128;
          const int ch = lane & 15;
          const f32x4 g0 = *(LAS const f32x4*)(sub + ch * 8), g1 = *(LAS const f32x4*)(sub + ch * 8 + 4);
#pragma unroll
          for (int i = 0; i < 8; ++i) { const int row = i * 4 + (lane >> 4); const u32x4 v = *(const LAS u32x4*)(stg + row * 128 + ch * 8);
              float d[8];
#pragma unroll
              for (int k = 0; k < 4; ++k) { d[2 * k] = __uint_as_float(v[k] << 16); d[2 * k + 1] = __uint_as_float(v[k] & 0xffff0000u); }
              float ss = ((d[0] * d[0] + d[1] * d[1]) + (d[2] * d[2] + d[3] * d[3])) + ((d[4] * d[4] + d[5] * d[5]) + (d[6] * d[6] + d[7] * d[7]));
              ss = row_sum16(ss);
              const float rs = 1.0f / sqrtf(ss * (1.0f / 128.0f) + RMS_EPS);
              u32x4 w; w.x = cvt_pk_bf16(d[0] * rs * g0[0], d[1] * rs * g0[1]); w.y = cvt_pk_bf16(d[2] * rs * g0[2], d[3] * rs * g0[3]);
              w.z = cvt_pk_bf16(d[4] * rs * g1[0], d[5] * rs * g1[1]); w.w = cvt_pk_bf16(d[6] * rs * g1[2], d[7] * rs * g1[3]);
              *(u32x4*)(Yw + (long)row * PITCH + ch * 8) = w; }
          asm volatile("" ::: "memory");
      } }
    asm volatile("s_waitcnt lgkmcnt(0)\n\ts_barrier" ::: "memory");
#undef ATT_DMA_K
#undef ATT_DMA_V
#undef ATT_ROT
#undef ATT_CMASK
#undef ATT_ROWMAX
#undef ATT_RESC
#undef ATT_KRD
#undef ATT_VRD
#undef ATT_VFR
#undef ATT_PKW
#undef ATT_PAF
#undef ATT_GAPA
#undef ATT_GAPB
#undef ATT_STEP
#undef ATT_ENDW
}
}

namespace ssm {
constexpr int TILE_PITCH = 272;
constexpr int S_BYTES = 32 * TILE_PITCH;
constexpr int WAVE_LDS = S_BYTES + 2048;
struct P { const float *a_re, *a_im, *log_dt, *b_re, *b_im, *c_re, *c_im, *dsk; };
__device__ __forceinline__ void csq(float& r, float& i) { const float nr = r * r - i * i, ni = 2.f * r * i; r = nr; i = ni; }
template <bool PASS2>
__device__ __forceinline__ void ssm_unit(const int wv, const int c0, const int g, const P& pr, const bf16_t* XN, float* EB, bf16_t* YG, LAS unsigned char* wl) {
    const int lane = opaque_tid(wv) & 63, pl = lane & 31, hi = lane >> 5;
    const float dt = __expf(pr.log_dt[g]);
    float abr[2], abi[2], a256r[2], a256i[2];
    bf16x8 fBre[2], fBim[2];
#pragma unroll
    for (int ph = 0; ph < 2; ++ph) {
        const int p = pl + 32 * ph;
        const float ar = pr.a_re[g * 64 + p], ai = pr.a_im[g * 64 + p];
        const float mag = __expf(ar * dt); float sn, cs; sincosf(ai * dt, &sn, &cs);
        abr[ph] = mag * cs; abi[ph] = mag * sn;
        const float den = ar * ar + ai * ai, nr = abr[ph] - 1.0f, ni = abi[ph];
        const float cr = (nr * ar + ni * ai) / den, ci = (ni * ar - nr * ai) / den;
        const f32x4* br = (const f32x4*)(pr.b_re + (size_t)(g * 64 + p) * 16 + 8 * hi); const f32x4* bi = (const f32x4*)(pr.b_im + (size_t)(g * 64 + p) * 16 + 8 * hi);
        const f32x4 br0 = br[0], br1 = br[1], bi0 = bi[0], bi1 = bi[1];
        float re[8], im[8];
#pragma unroll
        for (int j = 0; j < 4; ++j) { re[j] = cr * br0[j] - ci * bi0[j]; im[j] = cr * bi0[j] + ci * br0[j]; re[4 + j] = cr * br1[j] - ci * bi1[j]; im[4 + j] = cr * bi1[j] + ci * br1[j]; }
        u32x4 wre, wim;
#pragma unroll
        for (int j = 0; j < 4; ++j) { wre[j] = cvt_pk_bf16(re[2 * j], re[2 * j + 1]); wim[j] = cvt_pk_bf16(im[2 * j], im[2 * j + 1]); }
        fBre[ph] = __builtin_bit_cast(bf16x8, wre); fBim[ph] = __builtin_bit_cast(bf16x8, wim);
        float r = abr[ph], i = abi[ph]; csq(r, i); csq(r, i); csq(r, i); csq(r, i); csq(r, i); csq(r, i); csq(r, i); csq(r, i); csq(r, i); a256r[ph] = r; a256i[ph] = i;
    }
    bf16x8 fC[4]; float dskip = 0.f;
    if (PASS2) {
        const int ch = lane & 15, kg = lane >> 4;
#pragma unroll
        for (int ks = 0; ks < 4; ++ks) {
            const f32x4 cr = *(const f32x4*)(pr.c_re + (size_t)(g * 16 + ch) * 64 + 16 * ks + 4 * kg), ci = *(const f32x4*)(pr.c_im + (size_t)(g * 16 + ch) * 64 + 16 * ks + 4 * kg);
            u32x4 w;
#pragma unroll
            for (int j = 0; j < 4; ++j) w[j] = cvt_pk_bf16(cr[j], -ci[j]);
            fC[ks] = __builtin_bit_cast(bf16x8, w);
        }
        dskip = pr.dsk[g * 16 + ch];
    }
    float hr[2] = {0.f, 0.f}, hi_[2] = {0.f, 0.f};
    f32x2* const ep = (f32x2*)EB + ((size_t)(hi * SSM_G + g) * NCHUNK) * 64 + pl;
    if (PASS2) {
        const int nr_ = c0 >> 1;
        f32x2 ea[2][2];
#pragma unroll
        for (int k = 0; k < 2; ++k)
#pragma unroll
            for (int ph = 0; ph < 2; ++ph) ea[k][ph] = (k < nr_) ? ep[(size_t)(2 * k + 1) * 64 + ph * 32] : (f32x2){0.f, 0.f};
        for (int cc = 0; cc < nr_; cc += 2) {
            f32x2 eb[2][2];
#pragma unroll
            for (int k = 0; k < 2; ++k)
#pragma unroll
                for (int ph = 0; ph < 2; ++ph) eb[k][ph] = ea[k][ph];
            if (cc + 2 < nr_) {
#pragma unroll
                for (int k = 0; k < 2; ++k)
#pragma unroll
                    for (int ph = 0; ph < 2; ++ph) ea[k][ph] = (cc + 2 + k < nr_) ? ep[(size_t)(2 * (cc + 2 + k) + 1) * 64 + ph * 32] : (f32x2){0.f, 0.f}; }
#pragma unroll
            for (int k = 0; k < 2; ++k)
#pragma unroll
                for (int ph = 0; ph < 2; ++ph) { if (cc + k >= nr_) continue; const f32x2 e = eb[k][ph];
                    const float nr = a256r[ph] * hr[ph] - a256i[ph] * hi_[ph] + e.x, ni = a256r[ph] * hi_[ph] + a256i[ph] * hr[ph] + e.y; hr[ph] = nr; hi_[ph] = ni; }
        }
    }
    const int m_ = lane & 31; const int mb = (m_ >> 2) & 1, mr = (m_ & 3) + 4 * (m_ >> 3);
  for (int c = c0; c < c0 + 2; ++c) {
    const long t0 = (long)c * CHUNK;
    const bf16_t* up = XN + ((long)mb * SEQ + t0 + mr) * D + g * 16 + 8 * hi;
    bf16x8 uf = *(const bf16x8*)up;
    for (int sb = 0; sb < 16; ++sb) {
        bf16x8 ufn = uf;
        if (sb + 1 < 16) ufn = *(const bf16x8*)(up + (size_t)(sb + 1) * 16 * D);
        if (PASS2) { asm volatile("" ::: "memory"); *(LAS bf16x8*)(wl + S_BYTES + (16 * mb + mr) * 32 + hi * 16) = uf; asm volatile("" ::: "memory"); }
        f32x16 xr[2], xi[2];
#pragma unroll
        for (int ph = 0; ph < 2; ++ph) { xr[ph] = __builtin_amdgcn_mfma_f32_32x32x16_bf16(uf, fBre[ph], f32x16{}, 0, 0, 0); xi[ph] = __builtin_amdgcn_mfma_f32_32x32x16_bf16(uf, fBim[ph], f32x16{}, 0, 0, 0); }
#pragma unroll
        for (int ph = 0; ph < 2; ++ph) {
            const float ar = abr[ph], ai = abi[ph];
            float pr_ = hr[ph], pi_ = hi_[ph];
#pragma unroll
            for (int r = 0; r < 16; ++r) { xr[ph][r] += ar * pr_ - ai * pi_; xi[ph][r] += ar * pi_ + ai * pr_; pr_ = xr[ph][r]; pi_ = xi[ph][r]; }
            hr[ph] = pr_; hi_[ph] = pi_;
        }
        if (PASS2) {
#pragma unroll
            for (int ph = 0; ph < 2; ++ph)
#pragma unroll
                for (int r = 0; r < 16; ++r) *(LAS unsigned*)(wl + (16 * hi + r) * TILE_PITCH + (pl + 32 * ph) * 4) = cvt_pk_bf16(xr[ph][r], xi[ph][r]);
            asm volatile("" ::: "memory");
            const int ch = lane & 15, tg = lane >> 4;
#pragma unroll
            for (int mt = 0; mt < 2; ++mt) {
                f32x4 y = (f32x4){0.f, 0.f, 0.f, 0.f};
#pragma unroll
                for (int ks = 0; ks < 4; ++ks) { const bf16x8 af = *(const LAS bf16x8*)(wl + (16 * mt + ch) * TILE_PITCH + (16 * ks + 4 * tg) * 4);
                    y = __builtin_amdgcn_mfma_f32_16x16x32_bf16(af, fC[ks], y, 0, 0, 0); }
#pragma unroll
                for (int i = 0; i < 4; ++i) { const int tl = 16 * mt + 4 * tg + i;
                    const float u = bf2f(*(const LAS bf16_t*)(wl + S_BYTES + tl * 32 + ch * 2)); const float v = gelu_tanh(y[i] + dskip * u);
                    *(LAS bf16_t*)(wl + S_BYTES + 1024 + tl * 32 + ch * 2) = (bf16_t)(cvt_pk_bf16(v, 0.f) & 0xffffu); }
            }
            asm volatile("" ::: "memory");
            { const u32x4 yv = *(const LAS u32x4*)(wl + S_BYTES + 1024 + lane * 16); asm volatile("" ::: "memory");
              const int row = lane >> 1;
              *(u32x4*)(YG + ((size_t)(row >> 4) * SEQ + t0 + sb * 16 + (row & 15)) * D + g * 16 + (lane & 1) * 8) = yv; }
        }
        uf = ufn;
    }
    if (!PASS2 && c == c0 + 1) { ep[(size_t)c * 64] = (f32x2){hr[0], hi_[0]}; ep[(size_t)c * 64 + 32] = (f32x2){hr[1], hi_[1]}; }
  }
}
}

struct TokInfo { int s1, s2; float g1, g2; };

template <bool FP8 = false>
__device__ __forceinline__ void conv_item(const float* W, int K, int N, bf16_t* WT, int Nh, LAS float* scr, int item, int lane, const float* gain) {
    const int nblk = N / 32, kb = item / nblk, nb = item % nblk, k0 = 64 * kb, n0 = 32 * nb;
    const float g0 = gain ? gain[k0 + lane] : 1.0f;
#pragma unroll 8
    for (int i = 0; i < 32; ++i) { const int kk = 2 * i + (lane >> 5); scr[kk * 33 + (lane & 31)] = W[(size_t)(k0 + kk) * N + n0 + (lane & 31)]; }
    if (gain) { LDS_WAIT(); asm volatile("" ::: "memory");
#pragma unroll 8
        for (int i = 0; i < 33; ++i) { const int idx = lane * 33 + i; if (i < 32) scr[idx] *= g0; } }
    LDS_WAIT(); asm volatile("" ::: "memory");
    int r0 = n0;
    if (Nh) { const int hf = n0 / Nh, nn = n0 - hf * Nh; r0 = 256 * (nn / 128) + 128 * hf + (nn % 128); }
    const int c = lane & 7;
#pragma unroll
    for (int j = 0; j < 4; ++j) { const int n = (lane >> 3) + 8 * j; const LAS float* s = scr + (8 * c) * 33 + n;
        if constexpr (FP8) { u32x2 o; o.x = cvt_pk_fp8x4(s[0 * 33] * F8_W_MUL, s[1 * 33] * F8_W_MUL, s[2 * 33] * F8_W_MUL, s[3 * 33] * F8_W_MUL); o.y = cvt_pk_fp8x4(s[4 * 33] * F8_W_MUL, s[5 * 33] * F8_W_MUL, s[6 * 33] * F8_W_MUL, s[7 * 33] * F8_W_MUL);
            *(u32x2*)((unsigned char*)WT + (size_t)(r0 + n) * K + k0 + 8 * c) = o; }
        else { u32x4 o; o.x = cvt_pk_bf16(s[0 * 33], s[1 * 33]); o.y = cvt_pk_bf16(s[2 * 33], s[3 * 33]); o.z = cvt_pk_bf16(s[4 * 33], s[5 * 33]); o.w = cvt_pk_bf16(s[6 * 33], s[7 * 33]);
            *(u32x4*)(WT + (size_t)(r0 + n) * K + k0 + 8 * c) = o; } }
    LDS_WAIT(); asm volatile("" ::: "memory");
}

__device__ __forceinline__ void conv8_load(const float* W, int N, int item, int lane, float (&r)[32]) {
    const int nblk = N / 32, kb = item / nblk, nb = item % nblk, k0 = 64 * kb, n0 = 32 * nb;
#pragma unroll
    for (int i = 0; i < 32; ++i) { const int kk = 2 * i + (lane >> 5); r[i] = W[(size_t)(k0 + kk) * N + n0 + (lane & 31)]; }
}
__device__ __forceinline__ void conv8_finish(const float (&r)[32], int K, int N, unsigned char* WT, int Nh, LAS float* scr, int item, int lane) {
    const int nblk = N / 32, kb = item / nblk, nb = item % nblk, k0 = 64 * kb, n0 = 32 * nb;
#pragma unroll
    for (int i = 0; i < 32; ++i) { const int kk = 2 * i + (lane >> 5); scr[kk * 33 + (lane & 31)] = r[i]; }
    LDS_WAIT(); asm volatile("" ::: "memory");
    int r0 = n0;
    if (Nh) { const int hf = n0 / Nh, nn = n0 - hf * Nh; r0 = 256 * (nn / 128) + 128 * hf + (nn % 128); }
    const int c = lane & 7;
    const float wm = Nh ? (n0 >= Nh ? F8_W_MUL * F8_UP_FOLD : F8_W_MUL * F8_GATE_FOLD) : F8_W_MUL;
#pragma unroll
    for (int j = 0; j < 4; ++j) { const int n = (lane >> 3) + 8 * j; const LAS float* s = scr + (8 * c) * 33 + n;
        u32x2 o; o.x = cvt_pk_fp8x4(s[0 * 33] * wm, s[1 * 33] * wm, s[2 * 33] * wm, s[3 * 33] * wm); o.y = cvt_pk_fp8x4(s[4 * 33] * wm, s[5 * 33] * wm, s[6 * 33] * wm, s[7 * 33] * wm);
        *(u32x2*)(WT + (size_t)(r0 + n) * K + k0 + 8 * c) = o; }
    LDS_WAIT(); asm volatile("" ::: "memory");
}

struct Args { const float* in[26]; float* out; unsigned char* ws; int ph_lo, ph_hi; };

__device__ __forceinline__ f32x4 bf4_to_f32(u32x2 r) { f32x4 v; v[0] = __uint_as_float(r.x << 16); v[1] = __uint_as_float(r.x & 0xffff0000u); v[2] = __uint_as_float(r.y << 16); v[3] = __uint_as_float(r.y & 0xffff0000u); return v; }
__device__ __forceinline__ u32x2 f32_to_bf4(f32x4 v) { u32x2 w; w.x = cvt_pk_bf16(v[0], v[1]); w.y = cvt_pk_bf16(v[2], v[3]); return w; }
template <bool COMBINE, bool WRITE_X, bool FINAL, bool SRC16>
__device__ __forceinline__ void norm_row(const void* src, bf16_t* xdst, const float* gain, bf16_t* xn, float* fout, int row, int lane,
                                         const TokInfo* tok, const bf16_t* YM, const int (&tb)[NE + 1], f32x4 (&v)[4]) {
    if (SRC16) { const u32x2* xr = (const u32x2*)((const bf16_t*)src + (size_t)row * D) + lane;
#pragma unroll
        for (int j = 0; j < 4; ++j) v[j] = bf4_to_f32(xr[64 * j]); }
    else { const f32x4* xr = (const f32x4*)((const float*)src + (size_t)row * D) + lane;
#pragma unroll
        for (int j = 0; j < 4; ++j) v[j] = xr[64 * j]; }
    if (COMBINE) {
        const TokInfo ti = tok[row];
        int tb1 = 0, tb2 = 0; const int e1 = ti.s1 >> 20, e2 = ti.s2 >> 20;
#pragma unroll
        for (int k = 0; k < NE; ++k) { if (k == e1) tb1 = tb[k]; if (k == e2) tb2 = tb[k]; }
        const size_t r1 = (size_t)tb1 * 256 + (ti.s1 & 0xfffff), r2 = (size_t)tb2 * 256 + (ti.s2 & 0xfffff);
        const u32x2* y1 = (const u32x2*)(YM + r1 * D) + lane; const u32x2* y2 = (const u32x2*)(YM + r2 * D) + lane;
#pragma unroll
        for (int j = 0; j < 4; ++j) { const u32x2 a = y1[64 * j], c = y2[64 * j];
            v[j][0] += ti.g1 * __uint_as_float(a.x << 16) + ti.g2 * __uint_as_float(c.x << 16);
            v[j][1] += ti.g1 * __uint_as_float(a.x & 0xffff0000u) + ti.g2 * __uint_as_float(c.x & 0xffff0000u);
            v[j][2] += ti.g1 * __uint_as_float(a.y << 16) + ti.g2 * __uint_as_float(c.y << 16);
            v[j][3] += ti.g1 * __uint_as_float(a.y & 0xffff0000u) + ti.g2 * __uint_as_float(c.y & 0xffff0000u); }
    }
    if (WRITE_X) { u32x2* xo = (u32x2*)(xdst + (size_t)row * D) + lane;
#pragma unroll
        for (int j = 0; j < 4; ++j) xo[64 * j] = f32_to_bf4(v[j]); }
    float s = 0.f;
#pragma unroll
    for (int j = 0; j < 4; ++j) s += (v[j][0] * v[j][0] + v[j][1] * v[j][1]) + (v[j][2] * v[j][2] + v[j][3] * v[j][3]);
    const float rstd = 1.0f / sqrtf(wave_sum(s) * (1.0f / D) + RMS_EPS);
    const f32x4* gp = (const f32x4*)gain + lane;
#pragma unroll
    for (int j = 0; j < 4; ++j) { const f32x4 gg = gp[64 * j]; v[j] = v[j] * rstd * gg; }
    if (FINAL) { f32x4* fo = (f32x4*)(fout + (size_t)row * D) + lane;
#pragma unroll
        for (int j = 0; j < 4; ++j) fo[64 * j] = v[j]; }
    else if (xn) { u32x2* o8 = (u32x2*)(xn + (size_t)row * D) + lane;
#pragma unroll
        for (int j = 0; j < 4; ++j) o8[64 * j] = f32_to_bf4(v[j]); }
}

template <bool COMBINE, bool WRITE_X, bool FINAL, int NR, bool SRC16>
__device__ __forceinline__ void norm_rows(const void* src, bf16_t* xdst, const float* gain, bf16_t* xn, float* fout, int row0, int stride, int lane,
                                          const TokInfo* tok, const bf16_t* YM, const int (&tb)[NE + 1]) {
    f32x4 v[NR][4]; TokInfo ti[NR]; u32x2 ya[NR][4], yc[NR][4];
    if (COMBINE) {
#pragma unroll
        for (int k = 0; k < NR; ++k) ti[k] = tok[row0 + k * stride];
    }
#pragma unroll
    for (int k = 0; k < NR; ++k) {
        if (SRC16) { const u32x2* xr = (const u32x2*)((const bf16_t*)src + (size_t)(row0 + k * stride) * D) + lane;
#pragma unroll
            for (int j = 0; j < 4; ++j) v[k][j] = bf4_to_f32(xr[64 * j]); }
        else { const f32x4* xr = (const f32x4*)((const float*)src + (size_t)(row0 + k * stride) * D) + lane;
#pragma unroll
            for (int j = 0; j < 4; ++j) v[k][j] = xr[64 * j]; } }
    if (COMBINE) {
#pragma unroll
        for (int k = 0; k < NR; ++k) {
            int tb1 = 0, tb2 = 0; const int e1 = ti[k].s1 >> 20, e2 = ti[k].s2 >> 20;
#pragma unroll
            for (int q = 0; q < NE; ++q) { if (q == e1) tb1 = tb[q]; if (q == e2) tb2 = tb[q]; }
            const size_t r1 = (size_t)tb1 * 256 + (ti[k].s1 & 0xfffff), r2 = (size_t)tb2 * 256 + (ti[k].s2 & 0xfffff);
            const u32x2* y1 = (const u32x2*)(YM + r1 * D) + lane; const u32x2* y2 = (const u32x2*)(YM + r2 * D) + lane;
#pragma unroll
            for (int j = 0; j < 4; ++j) { ya[k][j] = y1[64 * j]; yc[k][j] = y2[64 * j]; }
        }
    }
    const f32x4* gp = (const f32x4*)gain + lane;
    f32x4 gg[4];
#pragma unroll
    for (int j = 0; j < 4; ++j) gg[j] = gp[64 * j];
#pragma unroll
    for (int k = 0; k < NR; ++k) {
        const int row = row0 + k * stride;
        if (COMBINE) {
#pragma unroll
            for (int j = 0; j < 4; ++j) { const u32x2 a = ya[k][j], c = yc[k][j];
                v[k][j][0] += ti[k].g1 * __uint_as_float(a.x << 16) + ti[k].g2 * __uint_as_float(c.x << 16);
                v[k][j][1] += ti[k].g1 * __uint_as_float(a.x & 0xffff0000u) + ti[k].g2 * __uint_as_float(c.x & 0xffff0000u);
                v[k][j][2] += ti[k].g1 * __uint_as_float(a.y << 16) + ti[k].g2 * __uint_as_float(c.y << 16);
                v[k][j][3] += ti[k].g1 * __uint_as_float(a.y & 0xffff0000u) + ti[k].g2 * __uint_as_float(c.y & 0xffff0000u); }
        }
        if (WRITE_X) { u32x2* xo = (u32x2*)(xdst + (size_t)row * D) + lane;
#pragma unroll
            for (int j = 0; j < 4; ++j) xo[64 * j] = f32_to_bf4(v[k][j]); }
        float sq = 0.f;
#pragma unroll
        for (int j = 0; j < 4; ++j) sq += (v[k][j][0] * v[k][j][0] + v[k][j][1] * v[k][j][1]) + (v[k][j][2] * v[k][j][2] + v[k][j][3] * v[k][j][3]);
        const float rstd = 1.0f / sqrtf(wave_sum(sq) * (1.0f / D) + RMS_EPS);
#pragma unroll
        for (int j = 0; j < 4; ++j) v[k][j] = v[k][j] * rstd * gg[j];
        if (FINAL) { f32x4* fo = (f32x4*)(fout + (size_t)row * D) + lane;
#pragma unroll
            for (int j = 0; j < 4; ++j) fo[64 * j] = v[k][j]; }
        else { u32x2* o8 = (u32x2*)(xn + (size_t)row * D) + lane;
#pragma unroll
            for (int j = 0; j < 4; ++j) o8[64 * j] = f32_to_bf4(v[k][j]); }
    }
}

__device__ __forceinline__ void load_tb(const gu32* cntw, int (&tb)[NE + 1], int (&cnt)[NE]) {
    int acc = 0;
#pragma unroll
    for (int e = 0; e < NE; ++e) { const int c = (int)__hip_atomic_load(cntw + e, RLX_AGENT); cnt[e] = c; tb[e] = acc; acc += (c + 255) >> 8; }
    tb[NE] = acc;
}

constexpr int N_PHASES = 32;
__global__ void __launch_bounds__(NWAVES * 64, 2) trunk_fwd(Args args) {
    extern __shared__ __attribute__((aligned(16))) unsigned char lds[];
    LAS unsigned char* const L = (LAS unsigned char*)lds;
    const int tid0 = threadIdx.x; const int wave0 = __builtin_amdgcn_readfirstlane(tid0 >> 6);
    const int G = gridDim.x; const int bx = blockIdx.x; const int vcu = (G % 8 == 0) ? (bx % 8) * (G / 8) + bx / 8 : bx;
#define PHASE_IDS const int tid = opaque_tid(wave0), lane = tid & 63, wave = wave0, gw = vcu * NWAVES + wave; (void)tid; (void)lane; (void)wave; (void)gw; \
    unsigned zoff_; asm volatile("s_mov_b32 %0, 0" : "=s"(zoff_)); unsigned char* const ws = ws0 + zoff_; float* const X = X0 + zoff_; gu32* const ctl = (gu32*)(ws + WS_CTL); (void)ctl; \
    bf16_t* const XN = (bf16_t*)(ws + WS_XN); bf16_t* const XR = (bf16_t*)(ws + WS_XR); (void)XR; bf16_t* const YG = (bf16_t*)(ws + WS_YG); float* const EB = (float*)(ws + WS_EB); \
    bf16_t* const QB = (bf16_t*)(ws + WS_Q); bf16_t* const KB = (bf16_t*)(ws + WS_K); bf16_t* const VB = (bf16_t*)(ws + WS_V); bf16_t* const OM = (bf16_t*)(ws + WS_OM); \
    bf16_t* const HID = (bf16_t*)(ws + WS_HID); bf16_t* const YM = (bf16_t*)(ws + WS_YM); float* const SSQ = (float*)(ws + WS_SSQ); LAS float* const PST = (LAS float*)(L + 131072); (void)SSQ; (void)PST; (void)XN; (void)YG; (void)EB; (void)QB; (void)KB; (void)VB; (void)OM; (void)HID; (void)YM; (void)X
    unsigned char* const ws0 = args.ws;
    gu32* const ctl0 = (gu32*)(ws0 + WS_CTL);
    for (int u = tid0; u < (LDS_BYTES - LDSCTL_OFF) / 4; u += NWAVES * 64) ((LAS unsigned*)(L + LDSCTL_OFF))[u] = 0u;
    __syncthreads();
    XcdBarrier bar; bar.bar = (unsigned*)(ctl0 + CW_BAR); bar.x = 0; bar.st = nullptr; bar.wv = wave0;
#if !MK_PER_PHASE
    bar = xcd_barrier_post((unsigned*)(ctl0 + CW_BAR), (volatile LAS unsigned*)(L + LDSCTL_OFF), wave0);
#endif
#if MK_PER_PHASE
    const int lo = args.ph_lo, hi_ph = args.ph_hi;
#define IN(k) (lo <= (k) && (k) < hi_ph)
#define SEAM(k) do { } while (0)
#else
#define IN(k) true
#define SEAM(k) do { xcd_barrier(bar); } while (0)
#endif
    const int NGW = G * NWAVES;
    float* const X0 = args.out;
    int tbz[NE + 1];
#pragma unroll
    for (int e = 0; e <= NE; ++e) tbz[e] = 0;

    if (PHON(0) && IN(0)) {
        PHASE_IDS;
        LAS float* scr = (LAS float*)(L + wave * 16384);
        constexpr int I_GLU = 16 * 64, I_QKV = 16 * 96, I_WO = 16 * 32, I_GU = 16 * 176, I_DN = 44 * 32;
        constexpr int C0 = 2 * I_GLU, C1 = C0 + 2 * I_QKV, C2 = C1 + 2 * I_WO, C3 = C2 + 2 * I_GU, C4 = C3 + 2 * I_DN;
        for (int rep_ = 0; rep_ < PHREP(0); ++rep_)
        for (int it = gw; it < C4; it += NGW) {
            if (it < C0) { const int m = it / I_GLU, r = it % I_GLU; conv_item(args.in[12] + (size_t)m * 1024 * 2048, 1024, 2048, (bf16_t*)(ws + WS_WGLU + m * SZ_WGLU), 1024, scr, r, lane, nullptr); }
            else if (it < C1) { const int q = it - C0, m = q / I_QKV, r = q % I_QKV; conv_item(args.in[13] + (size_t)m * 1024 * 3072, 1024, 3072, (bf16_t*)(ws + WS_WQKV + m * SZ_WQKV), 0, scr, r, lane, args.in[1] + (size_t)(2 * m + 1) * D); }
            else if (it < C2) { const int q = it - C1, m = q / I_WO, r = q % I_WO; conv_item(args.in[19] + (size_t)m * 1024 * 1024, 1024, 1024, (bf16_t*)(ws + WS_WO + m * SZ_WO), 0, scr, r, lane, nullptr); }
            else if (it < C3) { const int q = it - C2, m = q / I_GU, r = q % I_GU; conv_item(args.in[21] + (size_t)m * 1024 * 5632, 1024, 5632, (bf16_t*)(ws + WS_WGU + m * SZ_WGU), FF, scr, r, lane, args.in[2] + (size_t)(2 * m) * D); }
            else { const int q = it - C3, m = q / I_DN, r = q % I_DN; conv_item(args.in[22] + (size_t)m * 2816 * 1024, 2816, 1024, (bf16_t*)(ws + WS_WDN + m * SZ_WDN), 0, scr, r, lane, nullptr); }
        }
    }

    for (int lp = 0; lp < 2; ++lp) {
        const int pb = 1 + 15 * lp;
        const int li = 2 * lp;
        if (PHON(1) && IN(pb + 0)) {
        PHASE_IDS;
            const float* gain = args.in[1] + (size_t)li * D;
            if (lp == 0) { for (int m = gw; m < T; m += NGW) norm_rows<false, true, false, 1, false>(args.in[0], XR, gain, XN, nullptr, m, NGW, lane, nullptr, nullptr, tbz); }
            else { int tb[NE + 1], cnt[NE]; load_tb(ctl + CW_CNT + (lp - 1) * 64, tb, cnt); const TokInfo* tok = (const TokInfo*)(ws + WS_TOK) + (size_t)(lp - 1) * T;
                for (int m = gw; m < T; m += NGW) norm_rows<true, true, false, 1, true>(XR, XR, gain, XN, nullptr, m, NGW, lane, tok, YM, tb); }
            SEAM(pb + 0);
            if (PHREP(17) == 2) { for (int q_ = 0; q_ < 16; ++q_) xcd_barrier(bar); }
        }
        {
            ssm::P sp{args.in[4] + (size_t)lp * 4096, args.in[5] + (size_t)lp * 4096, args.in[6] + (size_t)lp * 64, args.in[7] + (size_t)lp * 65536, args.in[8] + (size_t)lp * 65536,
                      args.in[9] + (size_t)lp * 65536, args.in[10] + (size_t)lp * 65536, args.in[11] + (size_t)lp * D};
            if (PHON(2) && IN(pb + 1)) {
        PHASE_IDS;
                for (int rep_ = 0; rep_ < PHREP(2); ++rep_)
                for (int u = vcu; u < 8 * (NCHUNK / 2); u += G) { const int go = u & 7, j = u >> 3;
                    ssm::ssm_unit<false>(wave0, 2 * j, go * 8 + wave, sp, XN, EB, YG, L + wave * ssm::WAVE_LDS); }
                SEAM(pb + 1);
            }
            if (PHON(3) && IN(pb + 2)) {
        PHASE_IDS;
                for (int rep_ = 0; rep_ < PHREP(3); ++rep_)
                for (int u = vcu; u < 8 * (NCHUNK / 2); u += G) { const int go = u & 7, j = u >> 3;
                    ssm::ssm_unit<true>(wave0, 2 * j, go * 8 + wave, sp, XN, EB, YG, L + wave * ssm::WAVE_LDS); }
                SEAM(pb + 2);
            }
        }
        if (PHON(4) && IN(pb + 3)) {
        PHASE_IDS;
            pg8::DenseOrder S{T / 256, 2048 / 256, G, bx, D, (const bf16_t*)(ws + WS_WGLU + lp * SZ_WGLU)};
            pg8::EpiGluRes E{XR, D, pg8::RowSsq{SSQ, PST}};
            pg8::gemm_phase(wave0, L, YG, D, S, E);
            SEAM(pb + 3);
        }
        if (PHON(6) && IN(pb + 5)) {
        PHASE_IDS;
            pg8::DenseOrder S{T / 256, 5632 / 256, G, bx, D, (const bf16_t*)(ws + WS_WGU + lp * SZ_WGU)};
            pg8::EpiSwiGlu E{HID, FF, SSQ, 8};
            for (int rep_ = 0; rep_ < PHREP(6); ++rep_)
            pg8::gemm_phase(wave0, L, XR, D, S, E);
            SEAM(pb + 5);
        }
        if (PHON(7) && IN(pb + 6)) {
        PHASE_IDS;
            pg8::DenseOrder S{T / 256, 1024 / 256, G, bx, FF, (const bf16_t*)(ws + WS_WDN + lp * SZ_WDN), 1};
            pg8::EpiResAdd<true> E{XR, D, pg8::RowSsq{SSQ, PST}};
            pg8::gemm_phase(wave0, L, HID, FF, S, E);
            SEAM(pb + 6);
        }
        const int lo_i = 2 * lp + 1;
        if (PHON(9) && IN(pb + 8)) {
        PHASE_IDS;
            pg8::DenseOrder S{T / 256, 3072 / 256, G, bx, D, (const bf16_t*)(ws + WS_WQKV + lp * SZ_WQKV)};
            pg8::EpiBf16 E{QB, D, D, (size_t)T * D, 0.125f * LOG2E, SSQ, 4};
            for (int rep_ = 0; rep_ < PHREP(9); ++rep_)
            pg8::gemm_phase(wave0, L, XR, D, S, E);
            SEAM(pb + 8);
        }
        if (PHON(10) && IN(pb + 9)) {
        PHASE_IDS;
            {
                const float a = args.in[14][lp * 64 + lane] * args.in[15][lp * 64 + lane], c2 = args.in[16][lp * 64 + lane] * args.in[17][lp * 64 + lane]; const float s1 = wave_sum(a), s2 = wave_sum(c2);
                const float lam_init = 0.8f - 0.6f * __expf(-0.3f * (float)lo_i);
                LAS float* sub = (LAS float*)(L + att::LDS_SUB);
                if (tid < 128) sub[tid] = args.in[18][lp * 128 + tid] * (1.0f - lam_init);
                if (tid == 128) sub[128] = __expf(s1) - __expf(s2) + lam_init;
                __syncthreads();
            }
#define MOE_CHORE(part, nparts) do { constexpr int I_GU = 16 * 176, I_DN = 44 * 32, NIT = 8 * (I_GU + I_DN); \
                const int tidc = opaque_tid(wave0), lane = tidc & 63, wvc = __builtin_amdgcn_readfirstlane(tidc >> 6);        \
                LAS float* scrA = (LAS float*)(L + wvc * 17408); LAS float* scrB = scrA + 64 * 33; \
                for (int it = vcu * NWAVES + wvc + (part) * 2 * NGW; it < NIT; it += (nparts) * 2 * NGW) { float ra[32], rb[32]; const bool hb = it + NGW < NIT; const int itb = hb ? it + NGW : it;        \
                    const float* Wa; const float* Wb; unsigned char* Ta; unsigned char* Tb; int Ka, Na, Ha, ia, Kb, Nb, Hb, ib; \
                    if (it < 8 * I_GU) { const int m = 8 * lp + it / I_GU; ia = it % I_GU; Wa = args.in[24] + (size_t)m * 1024 * 5632; Ka = 1024; Na = 5632; Ha = FF; Ta = ws + WS_MGU + (size_t)m * (SZ_WGU / 2); } \
                    else { const int q = it - 8 * I_GU, m = 8 * lp + q / I_DN; ia = q % I_DN; Wa = args.in[25] + (size_t)m * 2816 * 1024; Ka = 2816; Na = 1024; Ha = 0; Ta = ws + WS_MDN + (size_t)m * (SZ_WDN / 2); } \
                    if (itb < 8 * I_GU) { const int m = 8 * lp + itb / I_GU; ib = itb % I_GU; Wb = args.in[24] + (size_t)m * 1024 * 5632; Kb = 1024; Nb = 5632; Hb = FF; Tb = ws + WS_MGU + (size_t)m * (SZ_WGU / 2); } \
                    else { const int q = itb - 8 * I_GU, m = 8 * lp + q / I_DN; ib = q % I_DN; Wb = args.in[25] + (size_t)m * 2816 * 1024; Kb = 2816; Nb = 1024; Hb = 0; Tb = ws + WS_MDN + (size_t)m * (SZ_WDN / 2); } \
                    conv8_load(Wa, Na, ia, lane, ra); conv8_load(Wb, Nb, ib, lane, rb); \
                    conv8_finish(ra, Ka, Na, Ta, Ha, scrA, ia, lane); if (hb) conv8_finish(rb, Kb, Nb, Tb, Hb, scrB, ib, lane); } \
                __syncthreads(); } while (0)
            for (int rep_ = 0; rep_ < PHREP(10); ++rep_)
            if (G == 256) {
                const int bh = vcu >> 4, s = vcu & 15;
                for (int i = 0; ; ++i) { int gq = bh, qb;
                    if (i < 3) qb = i == 0 ? 63 - s : i == 1 ? 32 + s : 31 - s;
                    else { LAS int* qslot = (LAS int*)(L + att::LDS_SUB + 768);
                        if (opaque_tid(wave0) == 0) *qslot = (int)__hip_atomic_fetch_add(ctl + CW_ATTQ + lp * 64, 1u, RLX_AGENT);
                        __syncthreads(); const int n = __builtin_amdgcn_readfirstlane(*qslot);
                        if (n >= 256 || rep_ != 0) break;
                        qb = 15 - (n >> 4); gq = n & 15; }
#pragma unroll 1
                    for (int mp = 0; mp < 2; ++mp) att::attn_unit(wave0, gq >> 3, 2 * (gq & 7) + mp, qb, QB, KB, VB, YG, args.in[20], (char*)lds);
                    if (i < 3 && rep_ == 0) MOE_CHORE(i, 3); }
            } else {
                for (int u = bx; u < 1024; u += G) {
#pragma unroll 1
                    for (int mp = 0; mp < 2; ++mp) att::attn_unit(wave0, u >> 9, 2 * ((u >> 6) & 7) + mp, u & 63, QB, KB, VB, YG, args.in[20], (char*)lds);
                    if (u == bx && rep_ == 0) MOE_CHORE(0, 1); }
                if (bx >= 1024 && rep_ == 0) MOE_CHORE(0, 1);
            }
#undef MOE_CHORE
            SEAM(pb + 9);
        }
        if (PHON(12) && IN(pb + 11)) {
        PHASE_IDS;
            pg8::DenseOrder S{T / 256, 1024 / 256, G, bx, D, (const bf16_t*)(ws + WS_WO + lp * SZ_WO)};
            pg8::EpiResAdd<false> E{XR, D, pg8::RowSsq{nullptr, PST}};
            pg8::gemm_phase(wave0, L, YG, D, S, E);
            SEAM(pb + 11);
        }
        if (PHON(13) && IN(pb + 12)) {
        PHASE_IDS;
            const float* gain = args.in[2] + (size_t)lo_i * D;
            const float* router = args.in[23] + (size_t)lp * D * NE;
            LAS int* lcnt = (LAS int*)(L + 32768);
            LAS int* lbase = (LAS int*)(L + 32768 + 64);
            LAS int* rec = (LAS int*)(L + 32768 + 128);
            TokInfo* tok = (TokInfo*)(ws + WS_TOK) + (size_t)lp * T;
            int* list = (int*)(ws + WS_LIST) + (size_t)lp * NE * T;
            unsigned char* xn_out = (unsigned char*)YG; gu32* cntw = ctl + CW_CNT + lp * 64;
            for (int rep_ = 0; rep_ < PHREP(13); ++rep_) {
            if (PHREP(13) == 2) { const bool dummy = rep_ == 0;
                tok = dummy ? (TokInfo*)(ws + WS_OM) : (TokInfo*)(ws + WS_TOK) + (size_t)lp * T; list = dummy ? (int*)(ws + WS_OM + 4 * MiB) : (int*)(ws + WS_LIST) + (size_t)lp * NE * T;
                xn_out = dummy ? (unsigned char*)HID : (unsigned char*)YG; cntw = dummy ? ctl + CW_CNT + 128 + lp * 64 : ctl + CW_CNT + lp * 64; }
            f32x4 Ra[4][4], Rb[4][4];
#pragma unroll
            for (int j = 0; j < 4; ++j)
#pragma unroll
                for (int i = 0; i < 4; ++i) { const f32x4* rp = (const f32x4*)(router + (size_t)(4 * lane + 256 * j + i) * NE); Ra[j][i] = rp[0]; Rb[j][i] = rp[1]; }
            f32x4 gg[4];
#pragma unroll
            for (int j = 0; j < 4; ++j) gg[j] = ((const f32x4*)gain + lane)[64 * j];
            for (int tt = bx; tt < T / 128; tt += G) {
                if (tid < 8) lcnt[tid] = 0;
                __syncthreads();
                u32x2 raw[4];
                { const u32x2* xr = (const u32x2*)(XR + (size_t)(tt * 128 + wave * 16) * D) + lane;
#pragma unroll
                  for (int j = 0; j < 4; ++j) raw[j] = xr[64 * j]; }
                for (int q = 0; q < 16; ++q) {
                    const int tl = wave * 16 + q, m = tt * 128 + tl;
                    u32x2 nraw[4];
                    { const u32x2* xr = (const u32x2*)(XR + (size_t)(q + 1 < 16 ? m + 1 : m) * D) + lane;
#pragma unroll
                      for (int j = 0; j < 4; ++j) nraw[j] = xr[64 * j]; }
                    f32x4 v[4];
                    { float sq = 0.f;
#pragma unroll
                      for (int j = 0; j < 4; ++j) { v[j] = bf4_to_f32(raw[j]); sq += (v[j][0] * v[j][0] + v[j][1] * v[j][1]) + (v[j][2] * v[j][2] + v[j][3] * v[j][3]); }
                      const float rstd = 1.0f / sqrtf(wave_sum(sq) * (1.0f / D) + RMS_EPS);
#pragma unroll
                      for (int j = 0; j < 4; ++j) { v[j] = v[j] * rstd * gg[j]; raw[j] = nraw[j]; } }
                    { unsigned* o4 = (unsigned*)(xn_out + (size_t)m * D) + lane;
#pragma unroll
                      for (int j = 0; j < 4; ++j) o4[64 * j] = cvt_pk_fp8x4(v[j][0] * F8_X_MUL, v[j][1] * F8_X_MUL, v[j][2] * F8_X_MUL, v[j][3] * F8_X_MUL); }
                    float lg[8];
#pragma unroll
                    for (int e = 0; e < 8; ++e) lg[e] = 0.f;
#pragma unroll
                    for (int j = 0; j < 4; ++j)
#pragma unroll
                        for (int i = 0; i < 4; ++i) { const f32x4 ra = Ra[j][i], rb = Rb[j][i];
                            const float h = v[j][i];
                            lg[0] += h * ra[0]; lg[1] += h * ra[1]; lg[2] += h * ra[2]; lg[3] += h * ra[3]; lg[4] += h * rb[0]; lg[5] += h * rb[1]; lg[6] += h * rb[2]; lg[7] += h * rb[3]; }
                    {
                        const float a0 = swap32_add(lg[0], lg[4]), a1 = swap32_add(lg[1], lg[5]), a2 = swap32_add(lg[2], lg[6]), a3 = swap32_add(lg[3], lg[7]);
                        const float b0 = row_sum16(swap16_add(a0, a2)), b1 = row_sum16(swap16_add(a1, a3));
                        const int i0 = __float_as_int(b0), i1 = __float_as_int(b1);
                        lg[0] = __int_as_float(__builtin_amdgcn_readlane(i0, 0)); lg[1] = __int_as_float(__builtin_amdgcn_readlane(i1, 0));
                        lg[2] = __int_as_float(__builtin_amdgcn_readlane(i0, 16)); lg[3] = __int_as_float(__builtin_amdgcn_readlane(i1, 16));
                        lg[4] = __int_as_float(__builtin_amdgcn_readlane(i0, 32)); lg[5] = __int_as_float(__builtin_amdgcn_readlane(i1, 32));
                        lg[6] = __int_as_float(__builtin_amdgcn_readlane(i0, 48)); lg[7] = __int_as_float(__builtin_amdgcn_readlane(i1, 48)); }
                    int e1 = 0; float l1 = lg[0];
#pragma unroll
                    for (int e = 1; e < 8; ++e) if (lg[e] > l1) { l1 = lg[e]; e1 = e; }
                    int e2 = -1; float l2 = -INFINITY;
#pragma unroll
                    for (int e = 0; e < 8; ++e) if (e != e1 && lg[e] > l2) { l2 = lg[e]; e2 = e; }
                    if (lane == 0) {
                        const float g1 = 1.0f / (1.0f + __expf(l2 - l1));
                        const int r1 = atomicAdd((int*)&lcnt[e1], 1), r2 = atomicAdd((int*)&lcnt[e2], 1);
                        rec[tl * 4 + 0] = e1; rec[tl * 4 + 1] = e2; rec[tl * 4 + 2] = r1; rec[tl * 4 + 3] = r2;
                        tok[m].g1 = g1; tok[m].g2 = 1.0f - g1;
                    }
                }
                __syncthreads();
                if (tid < 8) lbase[tid] = (int)__hip_atomic_fetch_add(cntw + tid, (unsigned)lcnt[tid], RLX_AGENT);
                __syncthreads();
                if (tid < 128) { const int m = tt * 128 + tid; const int e1 = rec[tid * 4], e2 = rec[tid * 4 + 1]; const int k1 = lbase[e1] + rec[tid * 4 + 2], k2 = lbase[e2] + rec[tid * 4 + 3];
                    list[(size_t)e1 * T + k1] = m; list[(size_t)e2 * T + k2] = m; tok[m].s1 = (e1 << 20) | k1; tok[m].s2 = (e2 << 20) | k2; }
                __syncthreads();
            }
            }
            SEAM(pb + 12);
        }
        if (PHON(14) && IN(pb + 13)) {
        PHASE_IDS;
            pg8::MoeOrder<true, true, F8_X_SC, F8_W_SC + 3> S; load_tb(ctl + CW_CNT + lp * 64, S.tb, S.cnt);
            S.nN = 5632 / 256; S.G = G; S.c = bx; S.K = D; S.Bt = (const unsigned char*)(ws + WS_MGU + (size_t)lp * 8 * (SZ_WGU / 2)); S.bstride = SZ_WGU / 2; S.list = (const int*)(ws + WS_LIST) + (size_t)lp * NE * T;
            pg8::EpiSwiGlu8 E{(unsigned char*)HID, FF};
            for (int rep_ = 0; rep_ < PHREP(14); ++rep_)
            pg8::gemm_phase(wave0, L, (const void*)YG, D, S, E);
            SEAM(pb + 13);
        }
        if (PHON(15) && IN(pb + 14)) {
        PHASE_IDS;
            pg8::MoeOrder<false, true, F8_H_SC> S; load_tb(ctl + CW_CNT + lp * 64, S.tb, S.cnt);
            S.nN = 1024 / 256; S.G = G; S.c = bx; S.K = FF; S.Bt = (const unsigned char*)(ws + WS_MDN + (size_t)lp * 8 * (SZ_WDN / 2)); S.bstride = SZ_WDN / 2; S.list = nullptr; S.rev = 1;
            pg8::EpiBf16Plain E{YM, D};
            for (int rep_ = 0; rep_ < PHREP(15); ++rep_)
            pg8::gemm_phase(wave0, L, HID, FF, S, E);
            SEAM(pb + 14);
        }
    }
    if (PHON(16) && IN(31)) {
        PHASE_IDS;
        int tb[NE + 1], cnt[NE]; load_tb(ctl + CW_CNT + 64, tb, cnt); const TokInfo* tok = (const TokInfo*)(ws + WS_TOK) + (size_t)T;
        for (int m = gw; m < T; m += NGW) norm_rows<true, false, true, 1, true>(XR, nullptr, args.in[3], nullptr, X, m, NGW, lane, tok, YM, tb);
    }
#undef IN
#undef SEAM
}

extern "C" void kernel_launch(void* const* d_in, const int* in_sizes, int n_in, void* d_out, int out_size, void* d_ws, size_t ws_size, hipStream_t stream) {
    static int grid = 0;
    if (grid == 0) {
        if (n_in != 26 || in_sizes[0] != T * D || out_size != T * D || ws_size < WS_END) { fprintf(stderr, "kernel_launch: unexpected shapes (n_in %d, ws %zu < %zu)\n", n_in, ws_size, (size_t)WS_END); grid = -1; return; }
        int dev = 0, cus = 0, per_cu = 0;
        if (hipGetDevice(&dev) != hipSuccess || hipDeviceGetAttribute(&cus, hipDeviceAttributeMultiprocessorCount, dev) != hipSuccess) { grid = -1; return; }
        if (hipFuncSetAttribute((const void*)trunk_fwd, hipFuncAttributeMaxDynamicSharedMemorySize, LDS_BYTES) != hipSuccess) { fprintf(stderr, "kernel_launch: hipFuncSetAttribute failed\n"); grid = -1; return; }
        if (hipOccupancyMaxActiveBlocksPerMultiprocessor(&per_cu, (const void*)trunk_fwd, NWAVES * 64, LDS_BYTES) != hipSuccess || per_cu < 1) { fprintf(stderr, "kernel_launch: occupancy query reports %d\n", per_cu); }
        (void)hipGetLastError();
        grid = cus;
    }
    if (grid < 0) return;
    (void)hipMemsetAsync((char*)d_ws + WS_CTL, 0, CTL_ZERO_BYTES, stream);
    Args a{};
    for (int i = 0; i < 26; ++i) a.in[i] = (const float*)d_in[i];
    a.out = (float*)d_out; a.ws = (unsigned char*)d_ws;
#if MK_PER_PHASE
    for (int p = 0; p < N_PHASES; ++p) { a.ph_lo = p; a.ph_hi = p + 1; hipLaunchKernelGGL(trunk_fwd, dim3(grid), dim3(NWAVES * 64), LDS_BYTES, stream, a); }
#else
    a.ph_lo = 0; a.ph_hi = N_PHASES;
    hipLaunchKernelGGL(trunk_fwd, dim3(grid), dim3(NWAVES * 64), LDS_BYTES, stream, a);
#endif
}
```

```cpp
#include <hip/hip_runtime.h>
#include <hip/hip_bf16.h>
#include <cstdio>
#include <cstdint>
#include <cmath>

#ifndef MK_PER_PHASE
#define MK_PER_PHASE 0
#endif

#ifndef PH_MASK
#define PH_MASK 0xffffffffu
#endif
#define PHON(k) (((PH_MASK) >> (k)) & 1u)
#ifndef PH_DOUBLE
#define PH_DOUBLE 0u
#endif
#define PHREP(k) ((((PH_DOUBLE) >> (k)) & 1u) ? 2 : 1)
#define GAS __attribute__((address_space(1)))
#define LAS __attribute__((address_space(3)))
typedef unsigned short bf16_t;
typedef short bf16x8 __attribute__((ext_vector_type(8)));
typedef short s16x4 __attribute__((ext_vector_type(4)));
typedef float f32x4 __attribute__((ext_vector_type(4)));
typedef float f32x2 __attribute__((ext_vector_type(2)));
typedef float f32x16 __attribute__((ext_vector_type(16)));
typedef unsigned u32x4 __attribute__((ext_vector_type(4)));
typedef unsigned u32x2 __attribute__((ext_vector_type(2)));
typedef int i32x4 __attribute__((ext_vector_type(4)));
typedef int i32x8 __attribute__((ext_vector_type(8)));
typedef GAS unsigned gu32;
#define RLX_AGENT __ATOMIC_RELAXED, __HIP_MEMORY_SCOPE_AGENT

constexpr int D = 1024, BATCH = 2, SEQ = 16384, T = BATCH * SEQ, FF = 2816, NE = 8;
constexpr int SSM_G = 64, SSM_P = 64, SSM_C = 16, NCHUNK = 64, CHUNK = 256;
constexpr float RMS_EPS = 1e-6f;
constexpr float LOG2E = 1.4426950408889634f;
constexpr int NWAVES = 8;
constexpr int MOE_ROWS = 2 * T + NE * 256;

constexpr size_t MiB = 1u << 20;
constexpr size_t WS_CTL = 0, CTL_ZERO_BYTES = 1 * MiB;
constexpr size_t SZ_WGLU = (size_t)2048 * 1024 * 2, SZ_WQKV = (size_t)3072 * 1024 * 2, SZ_WO = (size_t)1024 * 1024 * 2, SZ_WGU = (size_t)5632 * 1024 * 2, SZ_WDN = (size_t)1024 * 2816 * 2;
constexpr size_t WS_WGLU = 1 * MiB;
constexpr size_t WS_WQKV = WS_WGLU + 2 * SZ_WGLU;
constexpr size_t WS_WO = WS_WQKV + 2 * SZ_WQKV;
constexpr size_t WS_WGU = WS_WO + 2 * SZ_WO;
constexpr size_t WS_WDN = WS_WGU + 2 * SZ_WGU;
constexpr size_t WS_MGU = WS_WDN + 2 * SZ_WDN;
constexpr size_t WS_MDN = WS_MGU + 16 * SZ_WGU;
constexpr size_t WS_WEND = WS_MDN + 16 * SZ_WDN;
constexpr size_t WS_XN = (WS_WEND + MiB - 1) / MiB * MiB;
constexpr size_t WS_XR = WS_XN + (size_t)T * D * 2;
constexpr size_t WS_YG = WS_XR + (size_t)T * D * 2;
constexpr size_t WS_EB = WS_YG + (size_t)T * D * 2;
constexpr size_t WS_LIST = WS_EB + 4 * MiB;
constexpr size_t WS_TOK = WS_LIST + (size_t)2 * NE * T * 4;
constexpr size_t WS_SSQ = WS_TOK + (size_t)2 * T * 16;
constexpr size_t WS_YM = WS_SSQ + (size_t)T * 8 * 4;
constexpr size_t WS_RA = (WS_YM + (size_t)MOE_ROWS * D * 2 + MiB - 1) / MiB * MiB;
constexpr size_t WS_Q = WS_RA, WS_K = WS_Q + (size_t)T * D * 2, WS_V = WS_K + (size_t)T * D * 2, WS_OM = WS_V + (size_t)T * D * 2;
constexpr size_t WS_HID = WS_RA;
constexpr size_t WS_END = WS_RA + (size_t)MOE_ROWS * FF * 2;
static_assert(WS_OM + (size_t)T * 2048 * 2 <= WS_END, "overlay");
constexpr int CW_BAR = 4096;
constexpr int CW_CNT = 16384;
constexpr int CW_ATTQ = 20480;

constexpr int RING_BYTES = 147456;
constexpr int LDSCTL_OFF = RING_BYTES, LDS_BYTES = RING_BYTES + 1024;

#define LDS_WAIT() asm volatile("s_waitcnt lgkmcnt(0)" ::: "memory")
#define VM_WAIT() asm volatile("s_waitcnt vmcnt(0)" ::: "memory")

__device__ __forceinline__ unsigned cvt_pk_bf16(float lo, float hi) { unsigned r; asm volatile("v_cvt_pk_bf16_f32 %0, %1, %2" : "=v"(r) : "v"(lo), "v"(hi)); return r; }
__device__ __forceinline__ unsigned cvt_pk_fp8x4(float a, float b, float c, float d) {
    a = __builtin_amdgcn_fmed3f(a, -440.f, 440.f); b = __builtin_amdgcn_fmed3f(b, -440.f, 440.f); c = __builtin_amdgcn_fmed3f(c, -440.f, 440.f); d = __builtin_amdgcn_fmed3f(d, -440.f, 440.f);
    int p = __builtin_amdgcn_cvt_pk_fp8_f32(a, b, 0, false); p = __builtin_amdgcn_cvt_pk_fp8_f32(c, d, p, true); return (unsigned)p; }
constexpr float F8_W_MUL = 256.f, F8_X_MUL = 16.f, F8_H_MUL = 8.f;
constexpr int F8_W_SC = 127 - 8, F8_X_SC = 127 - 4, F8_H_SC = 127 - 3;
static_assert(F8_H_MUL == 8.f, "the up half MFMA scale (+3) carries F8_H_MUL");
constexpr float F8_GATE_FOLD = -1.4426950408889634f, F8_UP_FOLD = -0.6931471805599453f;
__device__ __forceinline__ float bf2f(unsigned short h) { return __uint_as_float(((unsigned)h) << 16); }
__device__ __forceinline__ float fast_exp2(float x) { return __builtin_amdgcn_exp2f(x); }
__device__ __forceinline__ float fast_rcp(float x) { return __builtin_amdgcn_rcpf(x); }
__device__ __forceinline__ float sigmoidf_(float x) { return fast_rcp(1.0f + fast_exp2(-x * LOG2E)); }
__device__ __forceinline__ float gelu_tanh(float x) { const float z = 0.7978845608028654f * (x + 0.044715f * x * x * x); return x * fast_rcp(1.0f + fast_exp2(-2.0f * LOG2E * z)); }
__device__ __forceinline__ int opaque_tid(int wv) { int l = (int)__builtin_amdgcn_mbcnt_hi(~0u, __builtin_amdgcn_mbcnt_lo(~0u, 0u)); asm volatile("" : "+v"(l)); return wv * 64 + l; }
template <int M> __device__ __forceinline__ float swz_xor(float v) { return __int_as_float(__builtin_amdgcn_ds_swizzle(__float_as_int(v), (M << 10) | 0x1f)); }
__device__ __forceinline__ float half_lo(float v) { auto rr = __builtin_amdgcn_permlane32_swap(__float_as_uint(v), __float_as_uint(v), false, false); return __uint_as_float(rr[0]); }
__device__ __forceinline__ float half_hi(float v) { auto rr = __builtin_amdgcn_permlane32_swap(__float_as_uint(v), __float_as_uint(v), false, false); return __uint_as_float(rr[1]); }
template <int CTRL> __device__ __forceinline__ float dpp_mov(float v) { return __int_as_float(__builtin_amdgcn_update_dpp(0, __float_as_int(v), CTRL, 0xf, 0xf, false)); }
__device__ __forceinline__ float row_sum16(float v) { v += dpp_mov<0x128>(v); v += dpp_mov<0x124>(v); v += dpp_mov<0x122>(v); v += dpp_mov<0x121>(v); return v; }
__device__ __forceinline__ float swap16_add(float x, float y) { auto rr = __builtin_amdgcn_permlane16_swap(__float_as_uint(x), __float_as_uint(y), false, false); return __uint_as_float(rr[0]) + __uint_as_float(rr[1]); }
__device__ __forceinline__ float swap32_add(float x, float y) { auto rr = __builtin_amdgcn_permlane32_swap(__float_as_uint(x), __float_as_uint(y), false, false); return __uint_as_float(rr[0]) + __uint_as_float(rr[1]); }
__device__ __forceinline__ float wave_sum(float v) { v = row_sum16(v); v = swap16_add(v, v); return swap32_add(v, v); }

#define XB_TMO      128
#define XB_XCNT(j)  (256  + 64 * (j))
#define XB_XSUB(j)  (1280 + 64 * (j))
#define XB_XGEN(j)  (2304 + 64 * (j))
#define XB_TOP      3328
#define XB_TOPGEN   3392
#define XCD_BAR_WORDS 3456
#define XB_SPIN_CAP (1u << 18)
__device__ __forceinline__ unsigned xb_ld(unsigned* p)              { return __hip_atomic_load(p, __ATOMIC_RELAXED, __HIP_MEMORY_SCOPE_AGENT); }
__device__ __forceinline__ unsigned xb_add(unsigned* p, unsigned v) { return __hip_atomic_fetch_add(p, v, __ATOMIC_RELAXED, __HIP_MEMORY_SCOPE_AGENT); }
__device__ __forceinline__ unsigned xb_xcc_id() { return (unsigned)__builtin_amdgcn_s_getreg((3 << 11) | 20) & 0xFu; }
#define XB_SPIN(cond, bar) do { unsigned _sp = 0; while (cond) { __builtin_amdgcn_s_sleep(1); \
    if ((++_sp & 255u) == 0u) { if (xb_ld(&(bar)[XB_TMO])) break; if (_sp > XB_SPIN_CAP) { atomicAdd(&(bar)[XB_TMO], 1u); break; } } } } while (0)
struct XcdBarrier { unsigned* bar; unsigned x; volatile LAS unsigned* st; int wv; };
__device__ __forceinline__ bool xb_thread0(int wv) { int l = (int)__builtin_amdgcn_mbcnt_hi(~0u, __builtin_amdgcn_mbcnt_lo(~0u, 0u)); asm volatile("" : "+v"(l)); return wv == 0 && l == 0; }
__device__ __forceinline__ XcdBarrier xcd_barrier_post(unsigned* bar, volatile LAS unsigned* st, int wv) {
    XcdBarrier b; b.bar = bar; b.x = xb_xcc_id(); b.st = st; b.wv = wv;
    if (xb_thread0(wv)) (void)xb_add(&bar[XB_XCNT(b.x)], 1u);
    return b;
}
__device__ __forceinline__ void xcd_barrier_complete(unsigned* bar, unsigned x, unsigned& nloc, unsigned& nx) {
    const unsigned G = gridDim.x * gridDim.y * gridDim.z;
    unsigned sum, cnt, mine, sp = 0u;
    for (;;) {
        sum = 0u; cnt = 0u; mine = 0u;
#pragma unroll
        for (unsigned j = 0; j < 16; ++j) { const unsigned c = xb_ld(&bar[XB_XCNT(j)]); sum += c; cnt += (c > 0u) ? 1u : 0u; mine = (j == x) ? c : mine; }
        if (sum == G) break;
        __builtin_amdgcn_s_sleep(1);
        if ((++sp & 255u) == 0u) { if (xb_ld(&bar[XB_TMO])) break; if (sp > XB_SPIN_CAP) { atomicAdd(&bar[XB_TMO], 1u); break; } }
    }
    nloc = mine > 0u ? mine : 1u; nx = cnt > 0u ? cnt : 1u;
}
__device__ __forceinline__ void xcd_barrier(const XcdBarrier& b) {
    asm volatile("s_waitcnt vmcnt(0)" ::: "memory");
    __syncthreads();
    if (xb_thread0(b.wv)) {
        unsigned* bar = b.bar;
        __builtin_amdgcn_s_waitcnt(0);
        unsigned nloc = b.st[0], nx = b.st[1];
        if (nloc == 0u) { xcd_barrier_complete(bar, b.x, nloc, nx); b.st[0] = nloc; b.st[1] = nx; }
        const unsigned old = xb_add(&bar[XB_XSUB(b.x)], 1u);
        const unsigned gen = old / nloc;
        if (old + 1u == (gen + 1u) * nloc) {
            __builtin_amdgcn_fence(__ATOMIC_RELEASE, "agent");
            asm volatile("s_waitcnt vmcnt(0)" ::: "memory");
            const unsigned og = xb_add(&bar[XB_TOP], 1u);
            const unsigned tg = og / nx;
            if (og + 1u == (tg + 1u) * nx) xb_add(&bar[XB_TOPGEN], 1u);
            else XB_SPIN(xb_ld(&bar[XB_TOPGEN]) == tg, bar);
            __builtin_amdgcn_fence(__ATOMIC_ACQUIRE, "agent");
            xb_add(&bar[XB_XGEN(b.x)], 1u);
            asm volatile("s_waitcnt vmcnt(0)" ::: "memory");
        } else {
            XB_SPIN(xb_ld(&bar[XB_XGEN(b.x)]) == gen, bar);
            __builtin_amdgcn_fence(__ATOMIC_ACQUIRE, "agent");
            asm volatile("s_waitcnt vmcnt(0)" ::: "memory");
        }
    }
    __syncthreads();
}

namespace pg8 {
constexpr int BM = 256, BK = 64, HALF = 128, HTB = HALF * BK * 2, STAGE_BYTES = 8 * HTB, NXCD = 8, WGM = 8;
__host__ __device__ __forceinline__ int lds_byte(int r, int c) { const int st = (r >> 4) * 2 + (c >> 5), rr = r & 15, cc = c & 31, ob = rr * 64 + cc * 2; return st * 1024 + (ob ^ (((ob >> 9) & 1) << 5)); }
__host__ __device__ __forceinline__ void stage_rc(int b, int& R, int& C) { const int st = b / 1024, sb = b % 1024, swz = sb ^ (((sb >> 9) & 1) << 5); R = (st >> 1) * 16 + swz / 64; C = (st & 1) * 32 + (swz % 64) / 2; }
__host__ __device__ __forceinline__ int perm32(int rho) { const int n = rho >> 4, i = rho & 15; return 8 * (i >> 2) + 4 * n + (i & 3); }

struct Unit { int pm, pn, e; };

__device__ __forceinline__ bool tile_order(int i, int G, int c, int nM, int nN, int& pm, int& pn) {
    const int nwg = nM * nN; const long L = (long)i * G + c; if (L >= nwg) return false;
    int wgid = (int)L; { const int q = nwg / NXCD, r = nwg % NXCD, xcd = wgid % NXCD, off = wgid / NXCD; wgid = (xcd < r ? xcd * (q + 1) : r * (q + 1) + (xcd - r) * q) + off; }
    const int nig = WGM * nN, gid = wgid / nig, fm = gid * WGM, gsz = (nM - fm) < WGM ? (nM - fm) : WGM;
    pm = fm + ((wgid % nig) % gsz); pn = (wgid % nig) / gsz; return true;
}
struct DenseOrder {
    int nM, nN, G, c, K; const bf16_t* Bt; int rev = 0;
    __device__ __forceinline__ bool next(int i, Unit& u) const { u.e = 0; if (!tile_order(i, G, c, nM, nN, u.pm, u.pn)) return false; if (rev) u.pm = nM - 1 - u.pm; return true; }
    static constexpr bool GATHER = false, FP8 = false; static constexpr int SC_W = 127, SC_W1 = 127, SC_A = 127;
    __device__ __forceinline__ void a_off(const Unit&, int, unsigned (&)[2][2]) const {}
    __device__ __forceinline__ const char* b_ptr(const Unit& u) const { return (const char*)Bt + (size_t)u.pn * BM * K * 2; }
};
template <bool GATHER_, bool FP8_, int SC_A_ = 127, int SC_W1_ = F8_W_SC> struct MoeOrder {
    static constexpr bool GATHER = GATHER_, FP8 = FP8_; static constexpr int SC_W = F8_W_SC, SC_W1 = SC_W1_, SC_A = SC_A_;
    int tb[NE + 1]; int cnt[NE]; int nN, G, c, K; const unsigned char* Bt; size_t bstride; const int* list; int rev = 0;
    __device__ __forceinline__ bool next(int i, Unit& u) const {
        if (!tile_order(i, G, c, tb[NE], nN, u.pm, u.pn)) return false;
        if (rev) u.pm = tb[NE] - 1 - u.pm;
        int e = 0;
#pragma unroll
        for (int k = 1; k < NE; ++k) e += (u.pm >= tb[k]) ? 1 : 0;
        u.e = e; return true;
    }
    __device__ __forceinline__ void a_off(const Unit& u, int tid, unsigned (&off)[2][2]) const {
        int R[2], C[2];
#pragma unroll
        for (int i = 0; i < 2; ++i) stage_rc(tid * 16 + i * 8192, R[i], C[i]);
        {
            int tbe = 0, ce = 0;
#pragma unroll
            for (int k = 0; k < NE; ++k) if (k == u.e) { tbe = tb[k]; ce = cnt[k]; }
            const int r0 = (u.pm - tbe) * BM; const int* lp = list + (size_t)u.e * T;
#pragma unroll
            for (int h = 0; h < 2; ++h)
#pragma unroll
                for (int i = 0; i < 2; ++i) { const int rk = r0 + h * HALF + R[i]; int tok = 0; if (rk < ce) tok = lp[rk]; off[h][i] = (unsigned)((size_t)tok * K + C[i] * 2); }
        }
    }
    __device__ __forceinline__ const char* b_ptr(const Unit& u) const { return (const char*)Bt + (size_t)u.e * bstride + (size_t)u.pn * BM * K; }
};

constexpr int SSQ_LD = 8;
struct RowSsq {
    float* ssq; LAS float* P;
    __device__ __forceinline__ void run(float (&part)[2][4], const Unit& u, int wr, int wc, int fr, int fq) const {
#pragma unroll
        for (int ai = 0; ai < 2; ++ai)
#pragma unroll
            for (int m = 0; m < 4; ++m) { float sq = part[ai][m]; sq = swap16_add(sq, sq); sq = swap32_add(sq, sq);
                if (fq == 0) P[(ai * HALF + wr * 64 + m * 16 + fr) * 4 + wc] = sq; }
        asm volatile("s_waitcnt lgkmcnt(0)" ::: "memory"); __builtin_amdgcn_s_barrier(); asm volatile("" ::: "memory");
        const int t_ = (wr * 4 + wc) * 64 + fq * 16 + fr;
        if (t_ < 256) { const f32x4 p = *(const LAS f32x4*)(P + t_ * 4); ssq[(size_t)(u.pm * BM + t_) * SSQ_LD + u.pn] = (p[0] + p[1]) + (p[2] + p[3]); }
    }
};
__device__ __forceinline__ float row_rstd(const float* ssq, int np, int row) {
    const f32x4 a = *(const f32x4*)(ssq + (size_t)row * SSQ_LD); float t = (a[0] + a[1]) + (a[2] + a[3]);
    if (np == 8) { const f32x4 b = *(const f32x4*)(ssq + (size_t)row * SSQ_LD + 4); t += (b[0] + b[1]) + (b[2] + b[3]); }
    return __builtin_amdgcn_rsqf(t * (1.0f / D) + RMS_EPS);
}
struct EpiBf16 {
    static constexpr bool PERM = true;
    bf16_t* O; int ldc; int split_cols; size_t split_stride; float scale0; const float* ssq; int np;
    __device__ __forceinline__ void operator()(const f32x4 (&acc)[2][2][4][2], const Unit& u, int wr, int wc, int fr, int fq) const {
        const int row0 = u.pm * BM + wr * 64 + fr; int colt = u.pn * BM; bf16_t* base = O;
        float sc0 = 1.f; if (split_cols) { const int t = colt / split_cols; base += (size_t)t * split_stride; colt -= t * split_cols; if (t == 0) sc0 = scale0; }
        const int col0 = colt + wc * 32 + 8 * fq;
#pragma unroll
        for (int ai = 0; ai < 2; ++ai)
#pragma unroll
            for (int m = 0; m < 4; ++m) { bf16_t* rowp = base + (size_t)(row0 + ai * HALF + m * 16) * ldc + col0;
                float sc = sc0; if (ssq) sc *= row_rstd(ssq, np, row0 + ai * HALF + m * 16);
#pragma unroll
                for (int bj = 0; bj < 2; ++bj) { const f32x4 v0 = acc[ai][bj][m][0] * sc, v1 = acc[ai][bj][m][1] * sc;
                    u32x4 w; w.x = cvt_pk_bf16(v0[0], v0[1]); w.y = cvt_pk_bf16(v0[2], v0[3]); w.z = cvt_pk_bf16(v1[0], v1[1]); w.w = cvt_pk_bf16(v1[2], v1[3]);
                    *(u32x4*)(rowp + bj * HALF) = w; } }
    }
};
struct EpiSwiGlu {
    static constexpr bool PERM = true;
    bf16_t* O; int ldc; const float* ssq; int np;
    __device__ __forceinline__ void operator()(const f32x4 (&acc)[2][2][4][2], const Unit& u, int wr, int wc, int fr, int fq) const {
        const int row0 = u.pm * BM + wr * 64 + fr; const int col0 = u.pn * HALF + wc * 32 + 8 * fq;
#pragma unroll
        for (int ai = 0; ai < 2; ++ai)
#pragma unroll
            for (int m = 0; m < 4; ++m) { bf16_t* rowp = O + (size_t)(row0 + ai * HALF + m * 16) * ldc + col0;
                float sc = 1.f; if (ssq) sc = row_rstd(ssq, np, row0 + ai * HALF + m * 16);
                const float sn = -sc * LOG2E, s2 = sc * sc;
                float r[8];
#pragma unroll
                for (int n = 0; n < 2; ++n)
#pragma unroll
                    for (int i = 0; i < 4; ++i) { const float a = acc[ai][0][m][n][i], b = acc[ai][1][m][n][i]; r[n * 4 + i] = (a * b) * s2 * fast_rcp(1.0f + fast_exp2(a * sn)); }
                u32x4 w; w.x = cvt_pk_bf16(r[0], r[1]); w.y = cvt_pk_bf16(r[2], r[3]); w.z = cvt_pk_bf16(r[4], r[5]); w.w = cvt_pk_bf16(r[6], r[7]);
                *(u32x4*)rowp = w; }
    }
};
struct EpiBf16Plain {
    static constexpr bool PERM = true;
    bf16_t* O; int ldc;
    __device__ __forceinline__ void operator()(const f32x4 (&acc)[2][2][4][2], const Unit& u, int wr, int wc, int fr, int fq) const {
        const int row0 = u.pm * BM + wr * 64 + fr; const int col0 = u.pn * BM + wc * 32 + 8 * fq;
#pragma unroll
        for (int ai = 0; ai < 2; ++ai)
#pragma unroll
            for (int m = 0; m < 4; ++m) { bf16_t* rowp = O + (size_t)(row0 + ai * HALF + m * 16) * ldc + col0;
#pragma unroll
                for (int bj = 0; bj < 2; ++bj) { const f32x4 v0 = acc[ai][bj][m][0], v1 = acc[ai][bj][m][1];
                    u32x4 w; w.x = cvt_pk_bf16(v0[0], v0[1]); w.y = cvt_pk_bf16(v0[2], v0[3]); w.z = cvt_pk_bf16(v1[0], v1[1]); w.w = cvt_pk_bf16(v1[2], v1[3]);
                    *(u32x4*)(rowp + bj * HALF) = w; } }
    }
};
struct EpiSwiGlu8 {
    static constexpr bool PERM = true;
    unsigned char* O; int ldc;
    __device__ __forceinline__ const float* ssq_src() const { return nullptr; }
    __device__ __forceinline__ void operator()(const f32x4 (&acc)[2][2][4][2], const Unit& u, int wr, int wc, int fr, int fq) const {
        const int row0 = u.pm * BM + wr * 64 + fr; const int col0 = u.pn * HALF + wc * 32 + 8 * fq;
#pragma unroll
        for (int ai = 0; ai < 2; ++ai)
#pragma unroll
            for (int m = 0; m < 4; ++m) { unsigned char* rowp = O + (size_t)(row0 + ai * HALF + m * 16) * ldc + col0;
                float r[8];
#pragma unroll
                for (int n = 0; n < 2; ++n)
#pragma unroll
                    for (int i = 0; i < 4; ++i) { const float g = acc[ai][0][m][n][i], up = acc[ai][1][m][n][i]; r[n * 4 + i] = g * up * fast_rcp(1.0f + fast_exp2(g)); }
                u32x2 w; w.x = cvt_pk_fp8x4(r[0], r[1], r[2], r[3]); w.y = cvt_pk_fp8x4(r[4], r[5], r[6], r[7]);
                *(u32x2*)rowp = w; }
    }
};
struct EpiGluRes {
    static constexpr bool PERM = true;
    bf16_t* xr; int ldc; RowSsq rs;
    __device__ __forceinline__ void operator()(const f32x4 (&acc)[2][2][4][2], const Unit& u, int wr, int wc, int fr, int fq) const {
        const int row0 = u.pm * BM + wr * 64 + fr; const int col0 = u.pn * HALF + wc * 32 + 8 * fq;
        float part[2][4]; u32x4 s[2][4];
#pragma unroll
        for (int ai = 0; ai < 2; ++ai)
#pragma unroll
            for (int m = 0; m < 4; ++m) s[ai][m] = *(const u32x4*)(xr + (size_t)(row0 + ai * HALF + m * 16) * ldc + col0);
#pragma unroll
        for (int ai = 0; ai < 2; ++ai)
#pragma unroll
            for (int m = 0; m < 4; ++m) { float o[8]; float sq = 0.f;
#pragma unroll
                for (int n = 0; n < 2; ++n)
#pragma unroll
                    for (int i = 0; i < 4; ++i) { const int k = n * 4 + i; const unsigned wd = s[ai][m][k >> 1]; const float sv = (k & 1) ? __uint_as_float(wd & 0xffff0000u) : __uint_as_float(wd << 16);
                        o[k] = sv + acc[ai][0][m][n][i] * sigmoidf_(acc[ai][1][m][n][i]); sq += o[k] * o[k]; }
                u32x4 w; w.x = cvt_pk_bf16(o[0], o[1]); w.y = cvt_pk_bf16(o[2], o[3]); w.z = cvt_pk_bf16(o[4], o[5]); w.w = cvt_pk_bf16(o[6], o[7]);
                *(u32x4*)(xr + (size_t)(row0 + ai * HALF + m * 16) * ldc + col0) = w; part[ai][m] = sq; }
        rs.run(part, u, wr, wc, fr, fq);
    }
};
template <bool STATS> struct EpiResAdd {
    static constexpr bool PERM = true;
    bf16_t* xr; int ldc; RowSsq rs;
    __device__ __forceinline__ void operator()(const f32x4 (&acc)[2][2][4][2], const Unit& u, int wr, int wc, int fr, int fq) const {
        const int row0 = u.pm * BM + wr * 64 + fr; const int col0 = u.pn * BM + wc * 32 + 8 * fq;
        float part[2][4];
#pragma unroll
        for (int ai = 0; ai < 2; ++ai) { u32x4 s[4][2];
#pragma unroll
            for (int m = 0; m < 4; ++m)
#pragma unroll
                for (int bj = 0; bj < 2; ++bj) s[m][bj] = *(const u32x4*)(xr + (size_t)(row0 + ai * HALF + m * 16) * ldc + col0 + bj * HALF);
#pragma unroll
            for (int m = 0; m < 4; ++m) { float sq = 0.f;
#pragma unroll
                for (int bj = 0; bj < 2; ++bj) { float o[8];
#pragma unroll
                    for (int n = 0; n < 2; ++n)
#pragma unroll
                        for (int i = 0; i < 4; ++i) { const int k = n * 4 + i; const unsigned wd = s[m][bj][k >> 1]; const float sv = (k & 1) ? __uint_as_float(wd & 0xffff0000u) : __uint_as_float(wd << 16);
                            o[k] = sv + acc[ai][bj][m][n][i]; if (STATS) sq += o[k] * o[k]; }
                    u32x4 w; w.x = cvt_pk_bf16(o[0], o[1]); w.y = cvt_pk_bf16(o[2], o[3]); w.z = cvt_pk_bf16(o[4], o[5]); w.w = cvt_pk_bf16(o[6], o[7]);
                    *(u32x4*)(xr + (size_t)(row0 + ai * HALF + m * 16) * ldc + col0 + bj * HALF) = w; }
                part[ai][m] = sq; } }
        if (STATS) rs.run(part, u, wr, wc, fr, fq);
    }
};

template <class Epi, class Sched>
__device__ __forceinline__ void gemm_phase(const int wv, LAS unsigned char* lds, const void* Abase, const int Kelems, const Sched& S, const Epi& E) {
    constexpr bool GATHER = Sched::GATHER, FP8 = Sched::FP8;
    const int tid = opaque_tid(wv), wid = wv, lane = tid & 63, wr = wid >> 2, wc = wid & 3, fr = lane & 15, fq = lane >> 4;
    const int K = FP8 ? (Kelems >> 1) : Kelems;
    const int nt = K / BK;
    unsigned voffA[2], voffB[2];
#pragma unroll
    for (int i = 0; i < 2; ++i) { int R, C; stage_rc(tid * 16 + i * 8192, R, C); const int Rb = Epi::PERM ? ((R & ~31) + perm32(R & 31)) : R;
        voffA[i] = (unsigned)(R * K + C) * 2u; voffB[i] = (unsigned)(Rb * K + C) * 2u; }
    LAS u32x4* const offn_lds = (LAS u32x4*)(lds + STAGE_BYTES + 4096) + tid;
    const size_t kstep = (size_t)(BK * 2);
    const size_t hstep = (size_t)HALF * K * 2;
    const size_t tstep = 2 * hstep;
    const unsigned ldsw = (unsigned)wid * 1024u;
    const int aoff = lds_byte(wr * 64 + fr, fq * 8), boff = lds_byte(wc * 32 + fr, fq * 8);
#define PG8_SA(b, h) (((b) * 2 + (h)) * HTB)
#define PG8_SB(b, h) ((4 + (b) * 2 + (h)) * HTB)
#define PG8_STAGE(bufoff, gbase, voff) do { _Pragma("unroll") for (int _i = 0; _i < 2; ++_i) \
        __builtin_amdgcn_global_load_lds((const unsigned*)((const char*)(gbase) + (voff)[_i]), (LAS unsigned*)(lds + (bufoff) + ldsw + _i * 8192), 16, 0, 0); } while (0)
#define PG8_STAGE_A(bufoff, h, base, og) do { if constexpr (GATHER) { PG8_STAGE(bufoff, base, og); } else { PG8_STAGE(bufoff, (base) + ((h) ? hstep : 0), voffA); } } while (0)
#define PG8_LD8(d8, addr) do { const i32x4 lo_ = *(const LAS i32x4*)(addr), hi_ = *(const LAS i32x4*)((addr) + 1024); \
        d8[0] = lo_[0]; d8[1] = lo_[1]; d8[2] = lo_[2]; d8[3] = lo_[3]; d8[4] = hi_[0]; d8[5] = hi_[1]; d8[6] = hi_[2]; d8[7] = hi_[3]; } while (0)
#define PG8_LDA(dst, b, h) do { if constexpr (FP8) { _Pragma("unroll") for (int m = 0; m < 4; ++m) PG8_LD8(dst##8[m], lds + PG8_SA(b, h) + aoff + m * 2048); } \
        else { _Pragma("unroll") for (int m = 0; m < 4; ++m) _Pragma("unroll") for (int k = 0; k < 2; ++k) dst[m][k] = *(const LAS bf16x8*)(lds + PG8_SA(b, h) + aoff + m * 2048 + k * 1024); } } while (0)
#define PG8_LDB(dst, b, h) do { if constexpr (FP8) { _Pragma("unroll") for (int n = 0; n < 2; ++n) PG8_LD8(dst##8[n], lds + PG8_SB(b, h) + boff + n * 2048); } \
        else { _Pragma("unroll") for (int n = 0; n < 2; ++n) _Pragma("unroll") for (int k = 0; k < 2; ++k) dst[n][k] = *(const LAS bf16x8*)(lds + PG8_SB(b, h) + boff + n * 2048 + k * 1024); } } while (0)
#define PG8_CAT8(x) __builtin_shufflevector(__builtin_bit_cast(i32x4, (x)[0]), __builtin_bit_cast(i32x4, (x)[1]), 0, 1, 2, 3, 4, 5, 6, 7)
#define PG8_MMA(ai, bj, At, Bt) do { __builtin_amdgcn_s_setprio(1); _Pragma("unroll") for (int m = 0; m < 4; ++m) _Pragma("unroll") for (int n = 0; n < 2; ++n) { \
        if constexpr (FP8) { asm volatile("v_mfma_scale_f32_16x16x128_f8f6f4 %0, %1, %2, %0, %3, %4 op_sel_hi:[0,0,0]" : "+v"(acc[ai][bj][m][n]) : "v"(Bt##8[n]), "v"(At##8[m]), "v"((bj) ? sc_w1_ : sc_w_), "v"(sc_a_)); }     \
        else { _Pragma("unroll") for (int k = 0; k < 2; ++k) acc[ai][bj][m][n] = __builtin_amdgcn_mfma_f32_16x16x32_bf16(Bt[n][k], At[m][k], acc[ai][bj][m][n], 0, 0, 0); } } \
        __builtin_amdgcn_s_setprio(0); } while (0)
#define PG8_WAIT_V(n) asm volatile("s_waitcnt vmcnt(" #n ")" ::: "memory")
#define PG8_WAIT_L(n) asm volatile("s_waitcnt lgkmcnt(" #n ")" ::: "memory")
#define PG8_BAR __builtin_amdgcn_s_barrier()
#define PG8_SCHED __builtin_amdgcn_sched_barrier(0)
    Unit cur, nxt; int ui = 0;
    if (!S.next(0, cur)) return;
    f32x4 acc[2][2][4][2];
#pragma unroll
    for (int a = 0; a < 2; ++a)
#pragma unroll
        for (int b = 0; b < 2; ++b)
#pragma unroll
            for (int m = 0; m < 4; ++m)
#pragma unroll
                for (int n = 0; n < 2; ++n) acc[a][b][m][n] = (f32x4){0.f, 0.f, 0.f, 0.f};
    const int sc_w_ = Sched::SC_W, sc_w1_ = Sched::SC_W1, sc_a_ = Sched::SC_A; (void)sc_w_; (void)sc_w1_; (void)sc_a_;
    bf16x8 At[4][2], B0[2][2], B1[2][2]; i32x8 At8[4], B08[2], B18[2];
    unsigned offC[2][2];
    if constexpr (GATHER) {
        S.a_off(cur, tid, offC);
        asm volatile("s_waitcnt vmcnt(0)" : "+v"(offC[0][0]), "+v"(offC[0][1]), "+v"(offC[1][0]), "+v"(offC[1][1]) :: "memory");
    }
    const char* cA = GATHER ? (const char*)Abase : (const char*)Abase + (size_t)cur.pm * tstep;
    const char* cB = S.b_ptr(cur);
    PG8_STAGE(PG8_SB(0, 0), cB, voffB); PG8_STAGE(PG8_SB(0, 1), cB + hstep, voffB); PG8_STAGE_A(PG8_SA(0, 0), 0, cA, offC[0]); PG8_STAGE_A(PG8_SA(0, 1), 1, cA, offC[1]);
    if (wr == 1) PG8_BAR;
    PG8_WAIT_V(2); PG8_BAR;
    PG8_STAGE(PG8_SB(1, 0), cB + kstep, voffB); PG8_STAGE_A(PG8_SA(1, 0), 0, cA + kstep, offC[0]); PG8_STAGE(PG8_SB(1, 1), cB + hstep + kstep, voffB);
    PG8_WAIT_V(6); PG8_BAR;
    for (;;) {
        const bool has_next = S.next(ui + 1, nxt);
        const char* nB = cB; const char* nA = cA;
        if (has_next) { nB = S.b_ptr(nxt); if constexpr (!GATHER) nA = (const char*)Abase + (size_t)nxt.pm * tstep; }
        bool reload = true;
        if constexpr (GATHER) reload = !(has_next && nxt.pm == cur.pm);
        if (GATHER && reload) {
            unsigned offN[2][2];
            if (has_next) S.a_off(nxt, tid, offN);
            else {
#pragma unroll
                for (int h = 0; h < 2; ++h)
#pragma unroll
                    for (int i = 0; i < 2; ++i) offN[h][i] = offC[h][i]; }
            asm volatile("s_waitcnt vmcnt(0)" : "+v"(offN[0][0]), "+v"(offN[0][1]), "+v"(offN[1][0]), "+v"(offN[1][1]) :: "memory");
            *offn_lds = (u32x4){offN[0][0], offN[0][1], offN[1][0], offN[1][1]};
        }
#pragma unroll 1
        for (int t = 0; t < nt; t += 2) {
            const bool last = (t == nt - 2);
            const char* a1 = cA + (size_t)(t + 1) * kstep;
            const char* a2 = last ? nA : cA + (size_t)(t + 2) * kstep; const char* b2 = last ? nB : cB + (size_t)(t + 2) * kstep;
            const char* a3 = a2 + kstep; const char* b3 = b2 + kstep;
            PG8_LDB(B0, 0, 0); PG8_LDB(B1, 0, 1); PG8_SCHED; PG8_LDA(At, 0, 0); PG8_STAGE_A(PG8_SA(1, 1), 1, a1, offC[1]);
            if constexpr (GATHER) { if (last && reload) { const u32x4 q_ = *offn_lds; offC[0][0] = q_[0]; offC[0][1] = q_[1]; offC[1][0] = q_[2]; offC[1][1] = q_[3]; } }
            PG8_WAIT_V(8); PG8_WAIT_L(0); PG8_BAR; PG8_MMA(0, 0, At, B0); PG8_MMA(0, 1, At, B1); PG8_BAR; PG8_SCHED;
            PG8_LDA(At, 0, 1); PG8_STAGE(PG8_SB(0, 0), b2, voffB); PG8_STAGE(PG8_SB(0, 1), b2 + hstep, voffB); PG8_STAGE_A(PG8_SA(0, 0), 0, a2, offC[0]);
            PG8_WAIT_V(8); PG8_WAIT_L(0); PG8_BAR; PG8_MMA(1, 0, At, B0); PG8_MMA(1, 1, At, B1); PG8_BAR; PG8_SCHED;
            PG8_LDB(B0, 1, 0); PG8_LDB(B1, 1, 1); PG8_SCHED; PG8_LDA(At, 1, 0); PG8_STAGE_A(PG8_SA(0, 1), 1, a2, offC[1]);
            PG8_WAIT_V(8); PG8_WAIT_L(0); PG8_BAR; PG8_MMA(0, 0, At, B0); PG8_MMA(0, 1, At, B1); PG8_BAR; PG8_SCHED;
            PG8_LDA(At, 1, 1); PG8_STAGE(PG8_SB(1, 0), b3, voffB); PG8_STAGE(PG8_SB(1, 1), b3 + hstep, voffB); PG8_STAGE_A(PG8_SA(1, 0), 0, a3, offC[0]);
            PG8_WAIT_V(8); PG8_WAIT_L(0); PG8_BAR; PG8_MMA(1, 0, At, B0); PG8_MMA(1, 1, At, B1); PG8_BAR; PG8_SCHED;
        }
        if (wr == 0) PG8_BAR;
        if constexpr (FP8) asm volatile("s_nop 15\n\ts_nop 15" ::: "memory");
        E(acc, cur, wr, wc, fr, fq);
        if (!has_next) break;
#pragma unroll
        for (int a = 0; a < 2; ++a)
#pragma unroll
            for (int b = 0; b < 2; ++b)
#pragma unroll
                for (int m = 0; m < 4; ++m)
#pragma unroll
                    for (int n = 0; n < 2; ++n) acc[a][b][m][n] = (f32x4){0.f, 0.f, 0.f, 0.f};
        cur = nxt; cB = nB; cA = nA; ++ui;
        if (wr == 1) PG8_BAR;
    }
    PG8_WAIT_V(0);
    PG8_BAR;
#undef PG8_SA
#undef PG8_SB
#undef PG8_STAGE
#undef PG8_STAGE_A
#undef PG8_LDA
#undef PG8_LD8
#undef PG8_LDB
#undef PG8_MMA
#undef PG8_CAT8
#undef PG8_WAIT_V
#undef PG8_WAIT_L
#undef PG8_BAR
#undef PG8_SCHED
}
}

namespace att {
constexpr int PITCH = 1024, OPITCH = 2048;
constexpr int KSLOT = 8192, VSLOT = 16384, NSLOT = 3;
constexpr int LDS_K = 0, LDS_V = NSLOT * KSLOT, LDS_WS = LDS_V + NSLOT * VSLOT, LDS_TAB = LDS_WS + 2048, LDS_OST = LDS_TAB + 512, LDS_SUB = LDS_OST + 8 * 8192, LDS_TOTAL = LDS_SUB + 1024;
static_assert(LDS_TOTAL <= RING_BYTES, "attention LDS");
__device__ __forceinline__ int crow(int r, int hi) { return (r & 3) + 8 * (r >> 2) + 4 * hi; }
__device__ __forceinline__ void glds16(const void* gsrc, unsigned lds_dst) { unsigned keep;
    asm volatile("s_mov_b32 %0, m0\n\ts_mov_b32 m0, %2\n\ts_nop 0\n\tglobal_load_lds_dwordx4 %1, off\n\ts_mov_b32 m0, %0" : "=&s"(keep) : "v"(gsrc), "s"(lds_dst) : "memory"); }
typedef LAS const char* lds_cptr;
typedef short v4i16_t __attribute__((ext_vector_type(4)));
__device__ __forceinline__ s16x4 vtr(lds_cptr p) { return __builtin_bit_cast(s16x4, __builtin_amdgcn_ds_read_tr16_b64_v4i16((LAS v4i16_t*)p)); }
#define ATT_WAIT_BAR(N) asm volatile("s_waitcnt vmcnt(" #N ") lgkmcnt(0)\n\ts_barrier" ::: "memory")

typedef __bf16 bf16x2_t __attribute__((ext_vector_type(2)));
__device__ __forceinline__ unsigned cvtpk_s(float lo, float hi) { f32x2 v = {lo, hi}; bf16x2_t b = __builtin_convertvector(v, bf16x2_t); return __builtin_bit_cast(unsigned, b); }
#define ATT_SBAR() __builtin_amdgcn_sched_barrier(0)
#define ATT_PIN(x) asm volatile("" : "+v"(x))
#define ATT_MFMA(a, b, c) __builtin_amdgcn_mfma_f32_32x32x16_bf16(a, b, c, 0, 0, 0)
__device__ __forceinline__ void attn_unit(const int wv, const int b, const int vh, const int qb, const bf16_t* Q, const bf16_t* __restrict__ Kt, const bf16_t* __restrict__ Vt, bf16_t* Y, const float* rel_bias, char* shm, const bool build_tab) {
    const int tid = opaque_tid(wv), lane = tid & 63, r32 = lane & 31, hi = lane >> 5; const int wid = wv;
    const long rowbase = (long)b * SEQ; const int q0 = qb * 256;
    const unsigned lds0 = (unsigned)(uintptr_t)shm;
    LAS float* wsf = (LAS float*)((LAS char*)shm + LDS_WS) + wid * 64;
    LAS float* tab = (LAS float*)((LAS char*)shm + LDS_TAB);
    if (build_tab && tid < 128) { const int d = tid; int bk = d;
        if (d >= 16) { bk = 16 + (int)(__logf((float)d * (1.0f / 16.0f)) / 2.0794415416798357f * 16.0f); bk = bk > 31 ? 31 : bk; }
        const int h = vh >> 1; tab[d] = (rel_bias[bk * 8 + h] - rel_bias[31 * 8 + h]) * LOG2E; }
    const bf16_t* Qw = Q + (rowbase + q0 + wid * 32) * PITCH + vh * 64;
    const bf16_t* Kh = Kt + rowbase * PITCH + vh * 64; const bf16_t* Vh = Vt + rowbase * PITCH + (vh >> 1) * 128;
    bf16x8 qr[4];
#pragma unroll
    for (int d0 = 0; d0 < 4; ++d0) qr[d0] = *reinterpret_cast<const bf16x8*>(&Qw[(long)r32 * PITCH + d0 * 16 + hi * 8]);
    asm volatile("s_waitcnt vmcnt(0)" : "+v"(qr[0]), "+v"(qr[1]), "+v"(qr[2]), "+v"(qr[3]) :: "memory");
    const bf16_t* ksrc = Kh + (long)lane * PITCH + wid * 8;
    const bf16_t* vsrc = Vh + (long)(16 * (wid & 3) + (lane >> 2)) * PITCH + (wid >> 2) * 32 + (lane & 3) * 8;
    const unsigned kdst = lds0 + LDS_K + wid * 1024, vdst = lds0 + LDS_V + wid * 1024;
#define ATT_DMA_K(t, sl) glds16(ksrc + (long)(t) * 64 * PITCH, (unsigned)__builtin_amdgcn_readfirstlane(kdst + (sl) * KSLOT))
#define ATT_DMA_V(t, sl) do { glds16(vsrc + (long)(t) * 64 * PITCH, (unsigned)__builtin_amdgcn_readfirstlane(vdst + (sl) * VSLOT)); \
        glds16(vsrc + (long)(t) * 64 * PITCH + 64, (unsigned)__builtin_amdgcn_readfirstlane(vdst + (sl) * VSLOT + 8192)); } while (0)
    const int NT = 4 * qb + 4;
    ATT_DMA_K(0, 0); ATT_DMA_K(1, 1); ATT_DMA_V(0, 0);
    const lds_cptr shm3 = (lds_cptr)shm;
    const lds_cptr kp0 = shm3 + LDS_K + hi * 1024 + r32 * 16;
    const lds_cptr vp0 = shm3 + LDS_V + ((lane >> 4) & 1) * 32 + (lane & 3) * 8 + (4 * hi + ((lane & 15) >> 2)) * 64;
    f32x16 o[4];
#pragma unroll
    for (int i = 0; i < 4; ++i) o[i] = f32x16{};
    float mhat = 0.f, l_reg = 0.f; f32x16 negm = f32x16{}; asm volatile("" : "+v"(negm));
    const int qpos = q0 + wid * 32 + r32; const int qfirst_w = q0 + wid * 32;
    bool resc = false;
    int s_prev = 0, s_cur = 0, s_next = 1;
#define ATT_ROT() do { s_prev = s_cur; s_cur = s_next; s_next = (s_next == 2) ? 0 : s_next + 1; } while (0)
#define ATT_CMASK(P0, P1, t) do { if (64 * (t) + 176 > qfirst_w) {     \
        const int kb_ = 64 * (t) + 4 * hi; \
        _Pragma("unroll") for (int r8 = 0; r8 < 16; r8 += 4) { float bb0_[4], bb1_[4]; \
            _Pragma("unroll") for (int r = r8; r < r8 + 4; ++r) { const int d0_ = qpos - (kb_ + (r & 3) + 8 * (r >> 2)), d1_ = d0_ - 32; \
                bb0_[r - r8] = tab[min(max(d0_, 0), 127)]; bb1_[r - r8] = tab[min(max(d1_, 0), 127)]; } \
            _Pragma("unroll") for (int r = r8; r < r8 + 4; ++r) { const int d0_ = qpos - (kb_ + (r & 3) + 8 * (r >> 2)), d1_ = d0_ - 32; \
                const float x0_ = P0[r] + bb0_[r - r8], x1_ = P1[r] + bb1_[r - r8];     \
                P0[r] = d0_ < 0 ? -INFINITY : x0_; P1[r] = d1_ < 0 ? -INFINITY : x1_; } } } } while (0)
#define ATT_ROWMAX(rm, P0, P1) do { float a_ = fmaxf(fmaxf(P0[0], P0[1]), P1[0]), b_ = fmaxf(fmaxf(P0[2], P0[3]), P1[1]); a_ = fmaxf(fmaxf(a_, P1[2]), P1[3]); \
        _Pragma("unroll") for (int r = 4; r < 16; r += 4) { a_ = fmaxf(fmaxf(a_, P0[r]), P0[r + 1]); b_ = fmaxf(fmaxf(b_, P0[r + 2]), P0[r + 3]); a_ = fmaxf(fmaxf(a_, P1[r]), P1[r + 1]); b_ = fmaxf(fmaxf(b_, P1[r + 2]), P1[r + 3]); } \
        rm = fmaxf(a_, b_); { auto rr_ = __builtin_amdgcn_permlane32_swap(__float_as_uint(rm), __float_as_uint(rm), false, false); rm = fmaxf(__uint_as_float(rr_[0]), __uint_as_float(rr_[1])); } } while (0)
#define ATT_RESC() do { if (resc) { _Pragma("unroll") for (int r = 0; r < 16; ++r) { const float f_ = wsf[crow(r, hi)]; _Pragma("unroll") for (int d_ = 0; d_ < 4; ++d_) o[d_][r] *= f_; } } } while (0)
    f32x16 pA0, pA1, pB0, pB1;
    u32x4 pw0, pw1, pw2, pw3;
    bf16x8 kfr[8]; s16x4 vlo[16], vhh[16];
#define ATT_KRD(i) do { kfr[i] = *(const LAS bf16x8*)(kp_ + ((i) >> 1) * 2048 + ((i) & 1) * 512); } while (0)
#define ATT_VRD(j) do { vlo[j] = vtr(vp_ + ((j) & 3) * 4096 + ((j) >> 2) * 1024); vhh[j] = vtr(vp_ + ((j) & 3) * 4096 + ((j) >> 2) * 1024 + 512); } while (0)
#define ATT_VFR(j) (bf16x8){vlo[j][0], vlo[j][1], vlo[j][2], vlo[j][3], vhh[j][0], vhh[j][1], vhh[j][2], vhh[j][3]}
    ATT_WAIT_BAR(3);
    ATT_DMA_K(2, 2); ATT_DMA_V(1, 1);
    { const lds_cptr kp_ = kp0;
#pragma unroll
      for (int i = 0; i < 8; ++i) ATT_KRD(i);
#pragma unroll
      for (int d0 = 0; d0 < 4; ++d0) { pA0 = ATT_MFMA(kfr[2 * d0], qr[d0], d0 == 0 ? negm : pA0); pA1 = ATT_MFMA(kfr[2 * d0 + 1], qr[d0], d0 == 0 ? negm : pA1); } }
    ATT_CMASK(pA0, pA1, 0);
    { float rm; ATT_ROWMAX(rm, pA0, pA1); mhat = rm;
#pragma unroll
      for (int r = 0; r < 16; ++r) { pA0[r] -= rm; pA1[r] -= rm; }
#pragma unroll
      for (int r = 0; r < 16; ++r) negm[r] = -mhat;
      asm volatile("" : "+v"(negm));
#pragma unroll
      for (int r = 0; r < 16; ++r) { pA0[r] = fast_exp2(pA0[r]); pA1[r] = fast_exp2(pA1[r]); } }
    ATT_WAIT_BAR(3);
    ATT_ROT();
#define ATT_PKW(P, B) cvtpk_s(P[B], P[(B) + 1])
#define ATT_PAF(k) __builtin_bit_cast(bf16x8, pw##k)
#define ATT_GAPA(i, C, INIT, A0, A1, A2, A3, W0, W1, PW) do { if ((i) + 3 < 8) ATT_KRD((i) + 3); if (DEEP_ && (i) >= 2) ATT_VRD((i) - 2); \
        C = ATT_MFMA(kfr[i], qr[(i) >> 1], INIT); sacc += A0; sacc += A1; sacc += A2; sacc += A3; ATT_PIN(sacc); W0; W1; ATT_PIN(PW); ATT_SBAR(); } while (0)
#define ATT_GAPB(j, KS, X, B) do { if ((j) + 6 < 16) ATT_VRD((j) + 6); o[(j) & 3] = ATT_MFMA(ATT_PAF(KS), ATT_VFR(j), o[(j) & 3]); \
        X[B] = fast_exp2(X[B]); X[(B) + 1] = fast_exp2(X[(B) + 1]); ATT_PIN(X); ATT_SBAR(); } while (0)
#define ATT_STEP(C0, C1, P0, P1, t, GK, GV, THR, DEEP) do { ATT_SBAR(); constexpr bool DEEP_ = (DEEP); \
        if (GK) ATT_DMA_K((t) + 2, s_prev); if (GV) ATT_DMA_V((t) + 1, s_next); \
        const lds_cptr kp_ = kp0 + s_cur * KSLOT; const lds_cptr vp_ = vp0 + s_prev * VSLOT; \
        ATT_KRD(0); ATT_KRD(1); ATT_KRD(2); ATT_SBAR(); float sacc = P0[0] + P0[1]; \
        ATT_GAPA(0, C0, negm, P0[2], P0[3], P0[4], P0[5],     pw0[0] = ATT_PKW(P0, 0),  pw0[1] = ATT_PKW(P0, 2),  pw0); \
        ATT_GAPA(1, C1, negm, P0[6], P0[7], P0[8], P0[9],     pw0[2] = ATT_PKW(P0, 4),  pw0[3] = ATT_PKW(P0, 6),  pw0); \
        ATT_GAPA(2, C0, C0,   P0[10], P0[11], P0[12], P0[13], pw1[0] = ATT_PKW(P0, 8),  pw1[1] = ATT_PKW(P0, 10), pw1); \
        ATT_GAPA(3, C1, C1,   P0[14], P0[15], P1[0], P1[1],   pw1[2] = ATT_PKW(P0, 12), pw1[3] = ATT_PKW(P0, 14), pw1); \
        ATT_GAPA(4, C0, C0,   P1[2], P1[3], P1[4], P1[5],     pw2[0] = ATT_PKW(P1, 0),  pw2[1] = ATT_PKW(P1, 2),  pw2); \
        ATT_GAPA(5, C1, C1,   P1[6], P1[7], P1[8], P1[9],     pw2[2] = ATT_PKW(P1, 4),  pw2[3] = ATT_PKW(P1, 6),  pw2); \
        ATT_GAPA(6, C0, C0,   P1[10], P1[11], P1[12], P1[13], pw3[0] = ATT_PKW(P1, 8),  pw3[1] = ATT_PKW(P1, 10), pw3); \
        ATT_GAPA(7, C1, C1,   P1[14], P1[15], 0.f, 0.f,       pw3[2] = ATT_PKW(P1, 12), pw3[3] = ATT_PKW(P1, 14), pw3); \
        l_reg += sacc; \
        ATT_CMASK(C0, C1, t); \
          \
          \
        { float rs_ = sacc; { auto rr_ = __builtin_amdgcn_permlane32_swap(__float_as_uint(rs_), __float_as_uint(rs_), false, false); rs_ = __uint_as_float(rr_[0]) + __uint_as_float(rr_[1]); } resc = false; \
          if (__builtin_expect(__any(rs_ > (float)(64 << (THR))), 0)) { const float dl = fmaxf(__builtin_amdgcn_logf(rs_) - 6.0f, 0.f); mhat += dl; \
            _Pragma("unroll") for (int r = 0; r < 16; ++r) { C0[r] -= dl; C1[r] -= dl; } \
            _Pragma("unroll") for (int r = 0; r < 16; ++r) negm[r] = -mhat; asm volatile("" : "+v"(negm)); \
            const float f = fast_exp2(-dl); l_reg *= f; if (hi == 0) wsf[r32] = f; resc = true; } } \
        ATT_SBAR(); \
        if (!DEEP_) { ATT_VRD(0); ATT_VRD(1); ATT_VRD(2); ATT_VRD(3); ATT_VRD(4); ATT_VRD(5); ATT_SBAR(); }     \
        ATT_GAPB(0, 0, C0, 0);   ATT_GAPB(1, 0, C0, 2);   ATT_GAPB(2, 0, C0, 4);   ATT_GAPB(3, 0, C0, 6); \
        ATT_GAPB(4, 1, C0, 8);   ATT_GAPB(5, 1, C0, 10);  ATT_GAPB(6, 1, C0, 12);  ATT_GAPB(7, 1, C0, 14); \
        ATT_GAPB(8, 2, C1, 0);   ATT_GAPB(9, 2, C1, 2);   ATT_GAPB(10, 2, C1, 4);  ATT_GAPB(11, 2, C1, 6); \
        ATT_GAPB(12, 3, C1, 8);  ATT_GAPB(13, 3, C1, 10); ATT_GAPB(14, 3, C1, 12); ATT_GAPB(15, 3, C1, 14); \
    } while (0)
    int t = 1;
#undef ATT_CMASK
#define ATT_CMASK(P0, P1, t) do { } while (0)
    for (; t + 7 < NT; t += 2) {
        ATT_STEP(pB0, pB1, pA0, pA1, t, true, true, 8, true);     ATT_WAIT_BAR(3); ATT_RESC(); ATT_ROT();
        ATT_STEP(pA0, pA1, pB0, pB1, t + 1, true, true, 8, true); ATT_WAIT_BAR(3); ATT_RESC(); ATT_ROT();
    }
#undef ATT_CMASK
#define ATT_CMASK(P0, P1, t) do { if (64 * (t) + 176 > qfirst_w) {     \
        const int kb_ = 64 * (t) + 4 * hi; \
        _Pragma("unroll") for (int r8 = 0; r8 < 16; r8 += 4) { float bb0_[4], bb1_[4]; \
            _Pragma("unroll") for (int r = r8; r < r8 + 4; ++r) { const int d0_ = qpos - (kb_ + (r & 3) + 8 * (r >> 2)), d1_ = d0_ - 32; \
                bb0_[r - r8] = tab[min(max(d0_, 0), 127)]; bb1_[r - r8] = tab[min(max(d1_, 0), 127)]; } \
            _Pragma("unroll") for (int r = r8; r < r8 + 4; ++r) { const int d0_ = qpos - (kb_ + (r & 3) + 8 * (r >> 2)), d1_ = d0_ - 32; \
                const float x0_ = P0[r] + bb0_[r - r8], x1_ = P1[r] + bb1_[r - r8];     \
                P0[r] = d0_ < 0 ? -INFINITY : x0_; P1[r] = d1_ < 0 ? -INFINITY : x1_; } } } } while (0)
#define ATT_ENDW(tt) do { if ((tt) + 2 < NT) { ATT_WAIT_BAR(3); } else { ATT_WAIT_BAR(0); } } while (0)
    for (; t + 1 < NT; t += 2) {
        ATT_STEP(pB0, pB1, pA0, pA1, t, (t + 2 < NT), (t + 1 < NT), 8, false);         ATT_ENDW(t);     ATT_RESC(); ATT_ROT();
        ATT_STEP(pA0, pA1, pB0, pB1, t + 1, (t + 3 < NT), (t + 2 < NT), 8, false);     ATT_ENDW(t + 1); ATT_RESC(); ATT_ROT();
    }
    ATT_STEP(pB0, pB1, pA0, pA1, NT - 1, false, false, 8, false); ATT_RESC();
    { float sacc = pB0[0] + pB0[1];
#pragma unroll
      for (int r = 2; r < 16; ++r) sacc += pB0[r];
#pragma unroll
      for (int r = 0; r < 16; ++r) sacc += pB1[r];
      l_reg += sacc;
      pw0 = (u32x4){ATT_PKW(pB0, 0), ATT_PKW(pB0, 2), ATT_PKW(pB0, 4), ATT_PKW(pB0, 6)}; pw1 = (u32x4){ATT_PKW(pB0, 8), ATT_PKW(pB0, 10), ATT_PKW(pB0, 12), ATT_PKW(pB0, 14)};
      pw2 = (u32x4){ATT_PKW(pB1, 0), ATT_PKW(pB1, 2), ATT_PKW(pB1, 4), ATT_PKW(pB1, 6)}; pw3 = (u32x4){ATT_PKW(pB1, 8), ATT_PKW(pB1, 10), ATT_PKW(pB1, 12), ATT_PKW(pB1, 14)};
      const lds_cptr vp_ = vp0 + s_cur * VSLOT;
#pragma unroll
      for (int d0 = 0; d0 < 4; ++d0) {
          const s16x4 l0 = vtr(vp_ + d0 * 4096), h0 = vtr(vp_ + d0 * 4096 + 512), l1 = vtr(vp_ + d0 * 4096 + 1024), h1 = vtr(vp_ + d0 * 4096 + 1536);
          const s16x4 l2 = vtr(vp_ + d0 * 4096 + 2048), h2 = vtr(vp_ + d0 * 4096 + 2560), l3 = vtr(vp_ + d0 * 4096 + 3072), h3 = vtr(vp_ + d0 * 4096 + 3584);
          o[d0] = ATT_MFMA(ATT_PAF(0), ((bf16x8){l0[0], l0[1], l0[2], l0[3], h0[0], h0[1], h0[2], h0[3]}), o[d0]);
          o[d0] = ATT_MFMA(ATT_PAF(1), ((bf16x8){l1[0], l1[1], l1[2], l1[3], h1[0], h1[1], h1[2], h1[3]}), o[d0]);
          o[d0] = ATT_MFMA(ATT_PAF(2), ((bf16x8){l2[0], l2[1], l2[2], l2[3], h2[0], h2[1], h2[2], h2[3]}), o[d0]);
          o[d0] = ATT_MFMA(ATT_PAF(3), ((bf16x8){l3[0], l3[1], l3[2], l3[3], h3[0], h3[1], h3[2], h3[3]}), o[d0]);
      } }
    { auto rr = __builtin_amdgcn_permlane32_swap(__float_as_uint(l_reg), __float_as_uint(l_reg), false, false); l_reg = __uint_as_float(rr[0]) + __uint_as_float(rr[1]); }
    if (hi == 0) wsf[32 + r32] = l_reg;
    { LAS bf16_t* stg = (LAS bf16_t*)((LAS char*)shm + LDS_OST) + wid * 4096;
      if ((vh & 1) == 0) {
#pragma unroll
          for (int r = 0; r < 16; ++r) { const int orow = crow(r, hi); const float rl = fast_rcp(wsf[32 + orow]);
#pragma unroll
              for (int d0 = 0; d0 < 4; ++d0) stg[orow * 128 + d0 * 32 + r32] = (bf16_t)cvtpk_s(o[d0][r] * rl, 0.f); }
          asm volatile("s_waitcnt lgkmcnt(0)" ::: "memory");
      } else {
          LAS const float* sub = (LAS const float*)((LAS char*)shm + LDS_SUB);
          const float lam = sub[128];
#pragma unroll
          for (int r = 0; r < 16; ++r) { const int orow = crow(r, hi); const float rl = fast_rcp(wsf[32 + orow]) * lam;
#pragma unroll
              for (int d0 = 0; d0 < 4; ++d0) { LAS bf16_t* p = stg + orow * 128 + d0 * 32 + r32; const float o1 = __uint_as_float(((unsigned)*p) << 16); *p = (bf16_t)cvtpk_s(o1 - o[d0][r] * rl, 0.f); } }
          asm volatile("s_waitcnt lgkmcnt(0)" ::: "memory");
          bf16_t* Yw = Y + (rowbase + q0 + wid * 32) * PITCH + (vh >> 1) * 128;
          const int ch = lane & 15;
          const f32x4 g0 = *(LAS const f32x4*)(sub + ch * 8), g1 = *(LAS const f32x4*)(sub + ch * 8 + 4);
#pragma unroll
          for (int i = 0; i < 8; ++i) { const int row = i * 4 + (lane >> 4); const u32x4 v = *(const LAS u32x4*)(stg + row * 128 + ch * 8);
              float d[8];
#pragma unroll
              for (int k = 0; k < 4; ++k) { d[2 * k] = __uint_as_float(v[k] << 16); d[2 * k + 1] = __uint_as_float(v[k] & 0xffff0000u); }
              float ss = ((d[0] * d[0] + d[1] * d[1]) + (d[2] * d[2] + d[3] * d[3])) + ((d[4] * d[4] + d[5] * d[5]) + (d[6] * d[6] + d[7] * d[7]));
              ss = row_sum16(ss);
              const float rs = __builtin_amdgcn_rsqf(ss * (1.0f / 128.0f) + RMS_EPS);
              u32x4 w; w.x = cvt_pk_bf16(d[0] * rs * g0[0], d[1] * rs * g0[1]); w.y = cvt_pk_bf16(d[2] * rs * g0[2], d[3] * rs * g0[3]);
              w.z = cvt_pk_bf16(d[4] * rs * g1[0], d[5] * rs * g1[1]); w.w = cvt_pk_bf16(d[6] * rs * g1[2], d[7] * rs * g1[3]);
              *(u32x4*)(Yw + (long)row * PITCH + ch * 8) = w; }
          asm volatile("" ::: "memory");
      } }
    asm volatile("s_waitcnt lgkmcnt(0)\n\ts_barrier" ::: "memory");
#undef ATT_DMA_K
#undef ATT_DMA_V
#undef ATT_ROT
#undef ATT_CMASK
#undef ATT_ROWMAX
#undef ATT_RESC
#undef ATT_KRD
#undef ATT_VRD
#undef ATT_VFR
#undef ATT_PKW
#undef ATT_PAF
#undef ATT_GAPA
#undef ATT_GAPB
#undef ATT_STEP
#undef ATT_ENDW
}
}

namespace ssm {
constexpr int TILE_PITCH = 272;
constexpr int S_BYTES = 32 * TILE_PITCH;
constexpr int WAVE_LDS = S_BYTES + 2048;
struct P { const float *a_re, *a_im, *log_dt, *b_re, *b_im, *c_re, *c_im, *dsk; };
__device__ __forceinline__ void csq(float& r, float& i) { const float nr = r * r - i * i, ni = 2.f * r * i; r = nr; i = ni; }
template <bool PASS2>
__device__ __forceinline__ void ssm_unit(const int wv, const int c0, const int g, const P& pr, const bf16_t* XN, float* EB, bf16_t* YG, LAS unsigned char* wl) {
    const int lane = opaque_tid(wv) & 63, pl = lane & 31, hi = lane >> 5;
    const float dt = __expf(pr.log_dt[g]);
    float abr[2], abi[2], a256r[2], a256i[2];
    bf16x8 fBre[2], fBim[2];
#pragma unroll
    for (int ph = 0; ph < 2; ++ph) {
        const int p = pl + 32 * ph;
        const float ar = pr.a_re[g * 64 + p], ai = pr.a_im[g * 64 + p];
        const float mag = __expf(ar * dt); float sn, cs; sincosf(ai * dt, &sn, &cs);
        abr[ph] = mag * cs; abi[ph] = mag * sn;
        const float den = ar * ar + ai * ai, nr = abr[ph] - 1.0f, ni = abi[ph];
        const float cr = (nr * ar + ni * ai) / den, ci = (ni * ar - nr * ai) / den;
        const f32x4* br = (const f32x4*)(pr.b_re + (size_t)(g * 64 + p) * 16 + 8 * hi); const f32x4* bi = (const f32x4*)(pr.b_im + (size_t)(g * 64 + p) * 16 + 8 * hi);
        const f32x4 br0 = br[0], br1 = br[1], bi0 = bi[0], bi1 = bi[1];
        float re[8], im[8];
#pragma unroll
        for (int j = 0; j < 4; ++j) { re[j] = cr * br0[j] - ci * bi0[j]; im[j] = cr * bi0[j] + ci * br0[j]; re[4 + j] = cr * br1[j] - ci * bi1[j]; im[4 + j] = cr * bi1[j] + ci * br1[j]; }
        u32x4 wre, wim;
#pragma unroll
        for (int j = 0; j < 4; ++j) { wre[j] = cvt_pk_bf16(re[2 * j], re[2 * j + 1]); wim[j] = cvt_pk_bf16(im[2 * j], im[2 * j + 1]); }
        fBre[ph] = __builtin_bit_cast(bf16x8, wre); fBim[ph] = __builtin_bit_cast(bf16x8, wim);
        float r = abr[ph], i = abi[ph]; csq(r, i); csq(r, i); csq(r, i); csq(r, i); csq(r, i); csq(r, i); csq(r, i); csq(r, i); csq(r, i); a256r[ph] = r; a256i[ph] = i;
    }
    bf16x8 fC[4]; float dskip = 0.f;
    if (PASS2) {
        const int ch = lane & 15, kg = lane >> 4;
#pragma unroll
        for (int ks = 0; ks < 4; ++ks) {
            const f32x4 cr = *(const f32x4*)(pr.c_re + (size_t)(g * 16 + ch) * 64 + 16 * ks + 4 * kg), ci = *(const f32x4*)(pr.c_im + (size_t)(g * 16 + ch) * 64 + 16 * ks + 4 * kg);
            u32x4 w;
#pragma unroll
            for (int j = 0; j < 4; ++j) w[j] = cvt_pk_bf16(cr[j], -ci[j]);
            fC[ks] = __builtin_bit_cast(bf16x8, w);
        }
        dskip = pr.dsk[g * 16 + ch];
    }
    float hr[2] = {0.f, 0.f}, hi_[2] = {0.f, 0.f};
    f32x2* const ep = (f32x2*)EB + ((size_t)(hi * SSM_G + g) * NCHUNK) * 64 + pl;
    if (PASS2) {
        const int nr_ = c0 >> 1;
        f32x2 ea[2][2];
#pragma unroll
        for (int k = 0; k < 2; ++k)
#pragma unroll
            for (int ph = 0; ph < 2; ++ph) ea[k][ph] = (k < nr_) ? ep[(size_t)(2 * k + 1) * 64 + ph * 32] : (f32x2){0.f, 0.f};
        for (int cc = 0; cc < nr_; cc += 2) {
            f32x2 eb[2][2];
#pragma unroll
            for (int k = 0; k < 2; ++k)
#pragma unroll
                for (int ph = 0; ph < 2; ++ph) eb[k][ph] = ea[k][ph];
            if (cc + 2 < nr_) {
#pragma unroll
                for (int k = 0; k < 2; ++k)
#pragma unroll
                    for (int ph = 0; ph < 2; ++ph) ea[k][ph] = (cc + 2 + k < nr_) ? ep[(size_t)(2 * (cc + 2 + k) + 1) * 64 + ph * 32] : (f32x2){0.f, 0.f}; }
#pragma unroll
            for (int k = 0; k < 2; ++k)
#pragma unroll
                for (int ph = 0; ph < 2; ++ph) { if (cc + k >= nr_) continue; const f32x2 e = eb[k][ph];
                    const float nr = a256r[ph] * hr[ph] - a256i[ph] * hi_[ph] + e.x, ni = a256r[ph] * hi_[ph] + a256i[ph] * hr[ph] + e.y; hr[ph] = nr; hi_[ph] = ni; }
        }
    }
    const int m_ = lane & 31; const int mb = (m_ >> 2) & 1, mr = (m_ & 3) + 4 * (m_ >> 3);
  for (int c = c0; c < c0 + 2; ++c) {
    const long t0 = (long)c * CHUNK;
    const bf16_t* up = XN + ((long)mb * SEQ + t0 + mr) * D + g * 16 + 8 * hi;
    bf16x8 uf = *(const bf16x8*)up;
    for (int sb = 0; sb < 16; ++sb) {
        bf16x8 ufn = uf;
        if (sb + 1 < 16) ufn = *(const bf16x8*)(up + (size_t)(sb + 1) * 16 * D);
        if (PASS2) { asm volatile("" ::: "memory"); *(LAS bf16x8*)(wl + S_BYTES + (16 * mb + mr) * 32 + hi * 16) = uf; asm volatile("" ::: "memory"); }
        f32x16 xr[2], xi[2];
#pragma unroll
        for (int ph = 0; ph < 2; ++ph) { xr[ph] = __builtin_amdgcn_mfma_f32_32x32x16_bf16(uf, fBre[ph], f32x16{}, 0, 0, 0); xi[ph] = __builtin_amdgcn_mfma_f32_32x32x16_bf16(uf, fBim[ph], f32x16{}, 0, 0, 0); }
#pragma unroll
        for (int ph = 0; ph < 2; ++ph) {
            const float ar = abr[ph], ai = abi[ph];
            float pr_ = hr[ph], pi_ = hi_[ph];
#pragma unroll
            for (int r = 0; r < 16; ++r) { xr[ph][r] += ar * pr_ - ai * pi_; xi[ph][r] += ar * pi_ + ai * pr_; pr_ = xr[ph][r]; pi_ = xi[ph][r]; }
            hr[ph] = pr_; hi_[ph] = pi_;
        }
        if (PASS2) {
#pragma unroll
            for (int ph = 0; ph < 2; ++ph)
#pragma unroll
                for (int r = 0; r < 16; ++r) *(LAS unsigned*)(wl + (16 * hi + r) * TILE_PITCH + (pl + 32 * ph) * 4) = cvt_pk_bf16(xr[ph][r], xi[ph][r]);
            asm volatile("" ::: "memory");
            const int ch = lane & 15, tg = lane >> 4;
#pragma unroll
            for (int mt = 0; mt < 2; ++mt) {
                f32x4 y = (f32x4){0.f, 0.f, 0.f, 0.f};
#pragma unroll
                for (int ks = 0; ks < 4; ++ks) { const bf16x8 af = *(const LAS bf16x8*)(wl + (16 * mt + ch) * TILE_PITCH + (16 * ks + 4 * tg) * 4);
                    y = __builtin_amdgcn_mfma_f32_16x16x32_bf16(af, fC[ks], y, 0, 0, 0); }
#pragma unroll
                for (int i = 0; i < 4; ++i) { const int tl = 16 * mt + 4 * tg + i;
                    const float u = bf2f(*(const LAS bf16_t*)(wl + S_BYTES + tl * 32 + ch * 2)); const float v = gelu_tanh(y[i] + dskip * u);
                    *(LAS bf16_t*)(wl + S_BYTES + 1024 + tl * 32 + ch * 2) = (bf16_t)(cvt_pk_bf16(v, 0.f) & 0xffffu); }
            }
            asm volatile("" ::: "memory");
            { const u32x4 yv = *(const LAS u32x4*)(wl + S_BYTES + 1024 + lane * 16); asm volatile("" ::: "memory");
              const int row = lane >> 1;
              *(u32x4*)(YG + ((size_t)(row >> 4) * SEQ + t0 + sb * 16 + (row & 15)) * D + g * 16 + (lane & 1) * 8) = yv; }
        }
        uf = ufn;
    }
    if (!PASS2 && c == c0 + 1) { ep[(size_t)c * 64] = (f32x2){hr[0], hi_[0]}; ep[(size_t)c * 64 + 32] = (f32x2){hr[1], hi_[1]}; }
  }
}
}

struct TokInfo { int s1, s2; float g1, g2; };

template <bool FP8 = false>
__device__ __forceinline__ void conv_item(const float* W, int K, int N, bf16_t* WT, int Nh, LAS float* scr, int item, int lane, const float* gain) {
    const int nblk = N / 32, kb = item / nblk, nb = item % nblk, k0 = 64 * kb, n0 = 32 * nb;
    const float g0 = gain ? gain[k0 + lane] : 1.0f;
#pragma unroll 8
    for (int i = 0; i < 32; ++i) { const int kk = 2 * i + (lane >> 5); scr[kk * 33 + (lane & 31)] = W[(size_t)(k0 + kk) * N + n0 + (lane & 31)]; }
    if (gain) { LDS_WAIT(); asm volatile("" ::: "memory");
#pragma unroll 8
        for (int i = 0; i < 33; ++i) { const int idx = lane * 33 + i; if (i < 32) scr[idx] *= g0; } }
    LDS_WAIT(); asm volatile("" ::: "memory");
    int r0 = n0;
    if (Nh) { const int hf = n0 / Nh, nn = n0 - hf * Nh; r0 = 256 * (nn / 128) + 128 * hf + (nn % 128); }
    const int c = lane & 7;
#pragma unroll
    for (int j = 0; j < 4; ++j) { const int n = (lane >> 3) + 8 * j; const LAS float* s = scr + (8 * c) * 33 + n;
        if constexpr (FP8) { u32x2 o; o.x = cvt_pk_fp8x4(s[0 * 33] * F8_W_MUL, s[1 * 33] * F8_W_MUL, s[2 * 33] * F8_W_MUL, s[3 * 33] * F8_W_MUL); o.y = cvt_pk_fp8x4(s[4 * 33] * F8_W_MUL, s[5 * 33] * F8_W_MUL, s[6 * 33] * F8_W_MUL, s[7 * 33] * F8_W_MUL);
            *(u32x2*)((unsigned char*)WT + (size_t)(r0 + n) * K + k0 + 8 * c) = o; }
        else { u32x4 o; o.x = cvt_pk_bf16(s[0 * 33], s[1 * 33]); o.y = cvt_pk_bf16(s[2 * 33], s[3 * 33]); o.z = cvt_pk_bf16(s[4 * 33], s[5 * 33]); o.w = cvt_pk_bf16(s[6 * 33], s[7 * 33]);
            *(u32x4*)(WT + (size_t)(r0 + n) * K + k0 + 8 * c) = o; } }
    LDS_WAIT(); asm volatile("" ::: "memory");
}

__device__ __forceinline__ void conv8_load(const float* W, int N, int item, int lane, float (&r)[32]) {
    const int nblk = N / 32, kb = item / nblk, nb = item % nblk, k0 = 64 * kb, n0 = 32 * nb;
#pragma unroll
    for (int i = 0; i < 32; ++i) { const int kk = 2 * i + (lane >> 5); r[i] = W[(size_t)(k0 + kk) * N + n0 + (lane & 31)]; }
}
__device__ __forceinline__ void conv8_finish(const float (&r)[32], int K, int N, unsigned char* WT, int Nh, LAS float* scr, int item, int lane) {
    const int nblk = N / 32, kb = item / nblk, nb = item % nblk, k0 = 64 * kb, n0 = 32 * nb;
#pragma unroll
    for (int i = 0; i < 32; ++i) { const int kk = 2 * i + (lane >> 5); scr[kk * 33 + (lane & 31)] = r[i]; }
    LDS_WAIT(); asm volatile("" ::: "memory");
    int r0 = n0;
    if (Nh) { const int hf = n0 / Nh, nn = n0 - hf * Nh; r0 = 256 * (nn / 128) + 128 * hf + (nn % 128); }
    const int c = lane & 7;
    const float wm = Nh ? (n0 >= Nh ? F8_W_MUL * F8_UP_FOLD : F8_W_MUL * F8_GATE_FOLD) : F8_W_MUL;
#pragma unroll
    for (int j = 0; j < 4; ++j) { const int n = (lane >> 3) + 8 * j; const LAS float* s = scr + (8 * c) * 33 + n;
        u32x2 o; o.x = cvt_pk_fp8x4(s[0 * 33] * wm, s[1 * 33] * wm, s[2 * 33] * wm, s[3 * 33] * wm); o.y = cvt_pk_fp8x4(s[4 * 33] * wm, s[5 * 33] * wm, s[6 * 33] * wm, s[7 * 33] * wm);
        *(u32x2*)(WT + (size_t)(r0 + n) * K + k0 + 8 * c) = o; }
    LDS_WAIT(); asm volatile("" ::: "memory");
}

struct Args { const float* in[26]; float* out; unsigned char* ws; int ph_lo, ph_hi; };

__device__ __forceinline__ f32x4 bf4_to_f32(u32x2 r) { f32x4 v; v[0] = __uint_as_float(r.x << 16); v[1] = __uint_as_float(r.x & 0xffff0000u); v[2] = __uint_as_float(r.y << 16); v[3] = __uint_as_float(r.y & 0xffff0000u); return v; }
__device__ __forceinline__ u32x2 f32_to_bf4(f32x4 v) { u32x2 w; w.x = cvt_pk_bf16(v[0], v[1]); w.y = cvt_pk_bf16(v[2], v[3]); return w; }
template <bool COMBINE, bool WRITE_X, bool FINAL, bool SRC16>
__device__ __forceinline__ void norm_row(const void* src, bf16_t* xdst, const float* gain, bf16_t* xn, float* fout, int row, int lane,
                                         const TokInfo* tok, const bf16_t* YM, const int (&tb)[NE + 1], f32x4 (&v)[4]) {
    if (SRC16) { const u32x2* xr = (const u32x2*)((const bf16_t*)src + (size_t)row * D) + lane;
#pragma unroll
        for (int j = 0; j < 4; ++j) v[j] = bf4_to_f32(xr[64 * j]); }
    else { const f32x4* xr = (const f32x4*)((const float*)src + (size_t)row * D) + lane;
#pragma unroll
        for (int j = 0; j < 4; ++j) v[j] = xr[64 * j]; }
    if (COMBINE) {
        const TokInfo ti = tok[row];
        int tb1 = 0, tb2 = 0; const int e1 = ti.s1 >> 20, e2 = ti.s2 >> 20;
#pragma unroll
        for (int k = 0; k < NE; ++k) { if (k == e1) tb1 = tb[k]; if (k == e2) tb2 = tb[k]; }
        const size_t r1 = (size_t)tb1 * 256 + (ti.s1 & 0xfffff), r2 = (size_t)tb2 * 256 + (ti.s2 & 0xfffff);
        const u32x2* y1 = (const u32x2*)(YM + r1 * D) + lane; const u32x2* y2 = (const u32x2*)(YM + r2 * D) + lane;
#pragma unroll
        for (int j = 0; j < 4; ++j) { const u32x2 a = y1[64 * j], c = y2[64 * j];
            v[j][0] += ti.g1 * __uint_as_float(a.x << 16) + ti.g2 * __uint_as_float(c.x << 16);
            v[j][1] += ti.g1 * __uint_as_float(a.x & 0xffff0000u) + ti.g2 * __uint_as_float(c.x & 0xffff0000u);
            v[j][2] += ti.g1 * __uint_as_float(a.y << 16) + ti.g2 * __uint_as_float(c.y << 16);
            v[j][3] += ti.g1 * __uint_as_float(a.y & 0xffff0000u) + ti.g2 * __uint_as_float(c.y & 0xffff0000u); }
    }
    if (WRITE_X) { u32x2* xo = (u32x2*)(xdst + (size_t)row * D) + lane;
#pragma unroll
        for (int j = 0; j < 4; ++j) xo[64 * j] = f32_to_bf4(v[j]); }
    float s = 0.f;
#pragma unroll
    for (int j = 0; j < 4; ++j) s += (v[j][0] * v[j][0] + v[j][1] * v[j][1]) + (v[j][2] * v[j][2] + v[j][3] * v[j][3]);
    const float rstd = 1.0f / sqrtf(wave_sum(s) * (1.0f / D) + RMS_EPS);
    const f32x4* gp = (const f32x4*)gain + lane;
#pragma unroll
    for (int j = 0; j < 4; ++j) { const f32x4 gg = gp[64 * j]; v[j] = v[j] * rstd * gg; }
    if (FINAL) { f32x4* fo = (f32x4*)(fout + (size_t)row * D) + lane;
#pragma unroll
        for (int j = 0; j < 4; ++j) fo[64 * j] = v[j]; }
    else if (xn) { u32x2* o8 = (u32x2*)(xn + (size_t)row * D) + lane;
#pragma unroll
        for (int j = 0; j < 4; ++j) o8[64 * j] = f32_to_bf4(v[j]); }
}

template <bool COMBINE, bool WRITE_X, bool FINAL, int NR, bool SRC16>
__device__ __forceinline__ void norm_rows(const void* src, bf16_t* xdst, const float* gain, bf16_t* xn, float* fout, int row0, int stride, int lane,
                                          const TokInfo* tok, const bf16_t* YM, const int (&tb)[NE + 1]) {
    f32x4 v[NR][4]; TokInfo ti[NR]; u32x2 ya[NR][4], yc[NR][4];
    if (COMBINE) {
#pragma unroll
        for (int k = 0; k < NR; ++k) ti[k] = tok[row0 + k * stride];
    }
#pragma unroll
    for (int k = 0; k < NR; ++k) {
        if (SRC16) { const u32x2* xr = (const u32x2*)((const bf16_t*)src + (size_t)(row0 + k * stride) * D) + lane;
#pragma unroll
            for (int j = 0; j < 4; ++j) v[k][j] = bf4_to_f32(xr[64 * j]); }
        else { const f32x4* xr = (const f32x4*)((const float*)src + (size_t)(row0 + k * stride) * D) + lane;
#pragma unroll
            for (int j = 0; j < 4; ++j) v[k][j] = xr[64 * j]; } }
    if (COMBINE) {
#pragma unroll
        for (int k = 0; k < NR; ++k) {
            int tb1 = 0, tb2 = 0; const int e1 = ti[k].s1 >> 20, e2 = ti[k].s2 >> 20;
#pragma unroll
            for (int q = 0; q < NE; ++q) { if (q == e1) tb1 = tb[q]; if (q == e2) tb2 = tb[q]; }
            const size_t r1 = (size_t)tb1 * 256 + (ti[k].s1 & 0xfffff), r2 = (size_t)tb2 * 256 + (ti[k].s2 & 0xfffff);
            const u32x2* y1 = (const u32x2*)(YM + r1 * D) + lane; const u32x2* y2 = (const u32x2*)(YM + r2 * D) + lane;
#pragma unroll
            for (int j = 0; j < 4; ++j) { ya[k][j] = y1[64 * j]; yc[k][j] = y2[64 * j]; }
        }
    }
    const f32x4* gp = (const f32x4*)gain + lane;
    f32x4 gg[4];
#pragma unroll
    for (int j = 0; j < 4; ++j) gg[j] = gp[64 * j];
#pragma unroll
    for (int k = 0; k < NR; ++k) {
        const int row = row0 + k * stride;
        if (COMBINE) {
#pragma unroll
            for (int j = 0; j < 4; ++j) { const u32x2 a = ya[k][j], c = yc[k][j];
                v[k][j][0] += ti[k].g1 * __uint_as_float(a.x << 16) + ti[k].g2 * __uint_as_float(c.x << 16);
                v[k][j][1] += ti[k].g1 * __uint_as_float(a.x & 0xffff0000u) + ti[k].g2 * __uint_as_float(c.x & 0xffff0000u);
                v[k][j][2] += ti[k].g1 * __uint_as_float(a.y << 16) + ti[k].g2 * __uint_as_float(c.y << 16);
                v[k][j][3] += ti[k].g1 * __uint_as_float(a.y & 0xffff0000u) + ti[k].g2 * __uint_as_float(c.y & 0xffff0000u); }
        }
        if (WRITE_X) { u32x2* xo = (u32x2*)(xdst + (size_t)row * D) + lane;
#pragma unroll
            for (int j = 0; j < 4; ++j) xo[64 * j] = f32_to_bf4(v[k][j]); }
        float sq = 0.f;
#pragma unroll
        for (int j = 0; j < 4; ++j) sq += (v[k][j][0] * v[k][j][0] + v[k][j][1] * v[k][j][1]) + (v[k][j][2] * v[k][j][2] + v[k][j][3] * v[k][j][3]);
        const float rstd = 1.0f / sqrtf(wave_sum(sq) * (1.0f / D) + RMS_EPS);
#pragma unroll
        for (int j = 0; j < 4; ++j) v[k][j] = v[k][j] * rstd * gg[j];
        if (FINAL) { f32x4* fo = (f32x4*)(fout + (size_t)row * D) + lane;
#pragma unroll
            for (int j = 0; j < 4; ++j) fo[64 * j] = v[k][j]; }
        else { u32x2* o8 = (u32x2*)(xn + (size_t)row * D) + lane;
#pragma unroll
            for (int j = 0; j < 4; ++j) o8[64 * j] = f32_to_bf4(v[k][j]); }
    }
}

__device__ __forceinline__ void load_tb(const gu32* cntw, int (&tb)[NE + 1], int (&cnt)[NE]) {
    int acc = 0;
#pragma unroll
    for (int e = 0; e < NE; ++e) { const int c = (int)__hip_atomic_load(cntw + e, RLX_AGENT); cnt[e] = c; tb[e] = acc; acc += (c + 255) >> 8; }
    tb[NE] = acc;
}

constexpr int N_PHASES = 32;
__global__ void __launch_bounds__(NWAVES * 64, 2) trunk_fwd(Args args) {
    extern __shared__ __attribute__((aligned(16))) unsigned char lds[];
    LAS unsigned char* const L = (LAS unsigned char*)lds;
    const int tid0 = threadIdx.x; const int wave0 = __builtin_amdgcn_readfirstlane(tid0 >> 6);
    const int G = gridDim.x; const int bx = blockIdx.x; const int vcu = (G % 8 == 0) ? (bx % 8) * (G / 8) + bx / 8 : bx;
#define PHASE_IDS const int tid = opaque_tid(wave0), lane = tid & 63, wave = wave0, gw = vcu * NWAVES + wave; (void)tid; (void)lane; (void)wave; (void)gw; \
    unsigned zoff_; asm volatile("s_mov_b32 %0, 0" : "=s"(zoff_)); unsigned char* const ws = ws0 + zoff_; float* const X = X0 + zoff_; gu32* const ctl = (gu32*)(ws + WS_CTL); (void)ctl; \
    bf16_t* const XN = (bf16_t*)(ws + WS_XN); bf16_t* const XR = (bf16_t*)(ws + WS_XR); (void)XR; bf16_t* const YG = (bf16_t*)(ws + WS_YG); float* const EB = (float*)(ws + WS_EB); \
    bf16_t* const QB = (bf16_t*)(ws + WS_Q); bf16_t* const KB = (bf16_t*)(ws + WS_K); bf16_t* const VB = (bf16_t*)(ws + WS_V); bf16_t* const OM = (bf16_t*)(ws + WS_OM); \
    bf16_t* const HID = (bf16_t*)(ws + WS_HID); bf16_t* const YM = (bf16_t*)(ws + WS_YM); float* const SSQ = (float*)(ws + WS_SSQ); LAS float* const PST = (LAS float*)(L + 131072); (void)SSQ; (void)PST; (void)XN; (void)YG; (void)EB; (void)QB; (void)KB; (void)VB; (void)OM; (void)HID; (void)YM; (void)X
    unsigned char* const ws0 = args.ws;
    gu32* const ctl0 = (gu32*)(ws0 + WS_CTL);
    for (int u = tid0; u < (LDS_BYTES - LDSCTL_OFF) / 4; u += NWAVES * 64) ((LAS unsigned*)(L + LDSCTL_OFF))[u] = 0u;
    __syncthreads();
    XcdBarrier bar; bar.bar = (unsigned*)(ctl0 + CW_BAR); bar.x = 0; bar.st = nullptr; bar.wv = wave0;
#if !MK_PER_PHASE
    bar = xcd_barrier_post((unsigned*)(ctl0 + CW_BAR), (volatile LAS unsigned*)(L + LDSCTL_OFF), wave0);
#endif
#if MK_PER_PHASE
    const int lo = args.ph_lo, hi_ph = args.ph_hi;
#define IN(k) (lo <= (k) && (k) < hi_ph)
#define SEAM(k) do { } while (0)
#else
#define IN(k) true
#define SEAM(k) do { xcd_barrier(bar); } while (0)
#endif
    const int NGW = G * NWAVES;
    float* const X0 = args.out;
    int tbz[NE + 1];
#pragma unroll
    for (int e = 0; e <= NE; ++e) tbz[e] = 0;

    if (PHON(0) && IN(0)) {
        PHASE_IDS;
        LAS float* scr = (LAS float*)(L + wave * 16384);
        constexpr int I_GLU = 16 * 64, I_QKV = 16 * 96, I_WO = 16 * 32, I_GU = 16 * 176, I_DN = 44 * 32;
        constexpr int C0 = 2 * I_GLU, C1 = C0 + 2 * I_QKV, C2 = C1 + 2 * I_WO, C3 = C2 + 2 * I_GU, C4 = C3 + 2 * I_DN;
        for (int rep_ = 0; rep_ < PHREP(0); ++rep_)
        for (int it = gw; it < C4; it += NGW) {
            if (it < C0) { const int m = it / I_GLU, r = it % I_GLU; conv_item(args.in[12] + (size_t)m * 1024 * 2048, 1024, 2048, (bf16_t*)(ws + WS_WGLU + m * SZ_WGLU), 1024, scr, r, lane, nullptr); }
            else if (it < C1) { const int q = it - C0, m = q / I_QKV, r = q % I_QKV; conv_item(args.in[13] + (size_t)m * 1024 * 3072, 1024, 3072, (bf16_t*)(ws + WS_WQKV + m * SZ_WQKV), 0, scr, r, lane, args.in[1] + (size_t)(2 * m + 1) * D); }
            else if (it < C2) { const int q = it - C1, m = q / I_WO, r = q % I_WO; conv_item(args.in[19] + (size_t)m * 1024 * 1024, 1024, 1024, (bf16_t*)(ws + WS_WO + m * SZ_WO), 0, scr, r, lane, nullptr); }
            else if (it < C3) { const int q = it - C2, m = q / I_GU, r = q % I_GU; conv_item(args.in[21] + (size_t)m * 1024 * 5632, 1024, 5632, (bf16_t*)(ws + WS_WGU + m * SZ_WGU), FF, scr, r, lane, args.in[2] + (size_t)(2 * m) * D); }
            else { const int q = it - C3, m = q / I_DN, r = q % I_DN; conv_item(args.in[22] + (size_t)m * 2816 * 1024, 2816, 1024, (bf16_t*)(ws + WS_WDN + m * SZ_WDN), 0, scr, r, lane, nullptr); }
        }
    }

    for (int lp = 0; lp < 2; ++lp) {
        const int pb = 1 + 15 * lp;
        const int li = 2 * lp;
        if (PHON(1) && IN(pb + 0)) {
        PHASE_IDS;
            const float* gain = args.in[1] + (size_t)li * D;
            if (lp == 0) { for (int m = gw; m < T; m += NGW) norm_rows<false, true, false, 1, false>(args.in[0], XR, gain, XN, nullptr, m, NGW, lane, nullptr, nullptr, tbz); }
            else { int tb[NE + 1], cnt[NE]; load_tb(ctl + CW_CNT + (lp - 1) * 64, tb, cnt); const TokInfo* tok = (const TokInfo*)(ws + WS_TOK) + (size_t)(lp - 1) * T;
                for (int m = gw; m < T; m += NGW) norm_rows<true, true, false, 1, true>(XR, XR, gain, XN, nullptr, m, NGW, lane, tok, YM, tb); }
            SEAM(pb + 0);
            if (PHREP(17) == 2) { for (int q_ = 0; q_ < 16; ++q_) xcd_barrier(bar); }
        }
        {
            ssm::P sp{args.in[4] + (size_t)lp * 4096, args.in[5] + (size_t)lp * 4096, args.in[6] + (size_t)lp * 64, args.in[7] + (size_t)lp * 65536, args.in[8] + (size_t)lp * 65536,
                      args.in[9] + (size_t)lp * 65536, args.in[10] + (size_t)lp * 65536, args.in[11] + (size_t)lp * D};
            if (PHON(2) && IN(pb + 1)) {
        PHASE_IDS;
                for (int rep_ = 0; rep_ < PHREP(2); ++rep_)
                for (int u = vcu; u < 8 * (NCHUNK / 2); u += G) { const int go = u & 7, j = u >> 3;
                    ssm::ssm_unit<false>(wave0, 2 * j, go * 8 + wave, sp, XN, EB, YG, L + wave * ssm::WAVE_LDS); }
                SEAM(pb + 1);
            }
            if (PHON(3) && IN(pb + 2)) {
        PHASE_IDS;
                for (int rep_ = 0; rep_ < PHREP(3); ++rep_)
                for (int u = vcu; u < 8 * (NCHUNK / 2); u += G) { const int go = u & 7, j = u >> 3;
                    ssm::ssm_unit<true>(wave0, 2 * j, go * 8 + wave, sp, XN, EB, YG, L + wave * ssm::WAVE_LDS); }
                SEAM(pb + 2);
            }
        }
        if (PHON(4) && IN(pb + 3)) {
        PHASE_IDS;
            pg8::DenseOrder S{T / 256, 2048 / 256, G, bx, D, (const bf16_t*)(ws + WS_WGLU + lp * SZ_WGLU)};
            pg8::EpiGluRes E{XR, D, pg8::RowSsq{SSQ, PST}};
            pg8::gemm_phase(wave0, L, YG, D, S, E);
            SEAM(pb + 3);
        }
        if (PHON(6) && IN(pb + 5)) {
        PHASE_IDS;
            pg8::DenseOrder S{T / 256, 5632 / 256, G, bx, D, (const bf16_t*)(ws + WS_WGU + lp * SZ_WGU)};
            pg8::EpiSwiGlu E{HID, FF, SSQ, 8};
            for (int rep_ = 0; rep_ < PHREP(6); ++rep_)
            pg8::gemm_phase(wave0, L, XR, D, S, E);
            SEAM(pb + 5);
        }
        if (PHON(7) && IN(pb + 6)) {
        PHASE_IDS;
            pg8::DenseOrder S{T / 256, 1024 / 256, G, bx, FF, (const bf16_t*)(ws + WS_WDN + lp * SZ_WDN), 1};
            pg8::EpiResAdd<true> E{XR, D, pg8::RowSsq{SSQ, PST}};
            pg8::gemm_phase(wave0, L, HID, FF, S, E);
            SEAM(pb + 6);
        }
        const int lo_i = 2 * lp + 1;
        if (PHON(9) && IN(pb + 8)) {
        PHASE_IDS;
            pg8::DenseOrder S{T / 256, 3072 / 256, G, bx, D, (const bf16_t*)(ws + WS_WQKV + lp * SZ_WQKV)};
            pg8::EpiBf16 E{QB, D, D, (size_t)T * D, 0.125f * LOG2E, SSQ, 4};
            for (int rep_ = 0; rep_ < PHREP(9); ++rep_)
            pg8::gemm_phase(wave0, L, XR, D, S, E);
            SEAM(pb + 8);
        }
        if (PHON(10) && IN(pb + 9)) {
        PHASE_IDS;
            {
                const float a = args.in[14][lp * 64 + lane] * args.in[15][lp * 64 + lane], c2 = args.in[16][lp * 64 + lane] * args.in[17][lp * 64 + lane]; const float s1 = wave_sum(a), s2 = wave_sum(c2);
                const float lam_init = 0.8f - 0.6f * __expf(-0.3f * (float)lo_i);
                LAS float* sub = (LAS float*)(L + att::LDS_SUB);
                if (tid < 128) sub[tid] = args.in[18][lp * 128 + tid] * (1.0f - lam_init);
                if (tid == 128) sub[128] = __expf(s1) - __expf(s2) + lam_init;
                __syncthreads();
            }
#define MOE_CHORE(part, nparts) do { constexpr int I_GU = 16 * 176, I_DN = 44 * 32, NIT = 8 * (I_GU + I_DN); \
                const int tidc = opaque_tid(wave0), lane = tidc & 63, wvc = __builtin_amdgcn_readfirstlane(tidc >> 6);        \
                LAS float* scrA = (LAS float*)(L + wvc * 17408); LAS float* scrB = scrA + 64 * 33; \
                for (int it = vcu * NWAVES + wvc + (part) * 2 * NGW; it < NIT; it += (nparts) * 2 * NGW) { float ra[32], rb[32]; const bool hb = it + NGW < NIT; const int itb = hb ? it + NGW : it;        \
                    const float* Wa; const float* Wb; unsigned char* Ta; unsigned char* Tb; int Ka, Na, Ha, ia, Kb, Nb, Hb, ib; \
                    if (it < 8 * I_GU) { const int m = 8 * lp + it / I_GU; ia = it % I_GU; Wa = args.in[24] + (size_t)m * 1024 * 5632; Ka = 1024; Na = 5632; Ha = FF; Ta = ws + WS_MGU + (size_t)m * (SZ_WGU / 2); } \
                    else { const int q = it - 8 * I_GU, m = 8 * lp + q / I_DN; ia = q % I_DN; Wa = args.in[25] + (size_t)m * 2816 * 1024; Ka = 2816; Na = 1024; Ha = 0; Ta = ws + WS_MDN + (size_t)m * (SZ_WDN / 2); } \
                    if (itb < 8 * I_GU) { const int m = 8 * lp + itb / I_GU; ib = itb % I_GU; Wb = args.in[24] + (size_t)m * 1024 * 5632; Kb = 1024; Nb = 5632; Hb = FF; Tb = ws + WS_MGU + (size_t)m * (SZ_WGU / 2); } \
                    else { const int q = itb - 8 * I_GU, m = 8 * lp + q / I_DN; ib = q % I_DN; Wb = args.in[25] + (size_t)m * 2816 * 1024; Kb = 2816; Nb = 1024; Hb = 0; Tb = ws + WS_MDN + (size_t)m * (SZ_WDN / 2); } \
                    conv8_load(Wa, Na, ia, lane, ra); conv8_load(Wb, Nb, ib, lane, rb); \
                    conv8_finish(ra, Ka, Na, Ta, Ha, scrA, ia, lane); if (hb) conv8_finish(rb, Kb, Nb, Tb, Hb, scrB, ib, lane); } \
                __syncthreads(); } while (0)
            for (int rep_ = 0; rep_ < PHREP(10); ++rep_)
            if (G == 256) {
                const int bh = vcu >> 4, s = vcu & 15;
                int tab_head = -1;
                for (int i = 0; ; ++i) { int gq = bh, qb;
                    if (i < 3) qb = i == 0 ? 63 - s : i == 1 ? 32 + s : 31 - s;
                    else { LAS int* qslot = (LAS int*)(L + att::LDS_SUB + 768);
                        if (opaque_tid(wave0) == 0) *qslot = (int)__hip_atomic_fetch_add(ctl + CW_ATTQ + lp * 64, 1u, RLX_AGENT);
                        __syncthreads(); const int n = __builtin_amdgcn_readfirstlane(*qslot);
                        if (n >= 256 || rep_ != 0) break;
                        qb = 15 - (n >> 4); gq = n & 15; }
#pragma unroll 1
                    for (int mp = 0; mp < 2; ++mp) { att::attn_unit(wave0, gq >> 3, 2 * (gq & 7) + mp, qb, QB, KB, VB, YG, args.in[20], (char*)lds, (gq & 7) != tab_head); tab_head = gq & 7; }
                    if (i < 3 && rep_ == 0) { MOE_CHORE(i, 3); tab_head = -1; } }
            } else {
                for (int u = bx; u < 1024; u += G) {
#pragma unroll 1
                    for (int mp = 0; mp < 2; ++mp) att::attn_unit(wave0, u >> 9, 2 * ((u >> 6) & 7) + mp, u & 63, QB, KB, VB, YG, args.in[20], (char*)lds, true);
                    if (u == bx && rep_ == 0) MOE_CHORE(0, 1); }
                if (bx >= 1024 && rep_ == 0) MOE_CHORE(0, 1);
            }
#undef MOE_CHORE
            SEAM(pb + 9);
        }
        if (PHON(12) && IN(pb + 11)) {
        PHASE_IDS;
            pg8::DenseOrder S{T / 256, 1024 / 256, G, bx, D, (const bf16_t*)(ws + WS_WO + lp * SZ_WO)};
            pg8::EpiResAdd<false> E{XR, D, pg8::RowSsq{nullptr, PST}};
            pg8::gemm_phase(wave0, L, YG, D, S, E);
            SEAM(pb + 11);
        }
        if (PHON(13) && IN(pb + 12)) {
        PHASE_IDS;
            const float* gain = args.in[2] + (size_t)lo_i * D;
            const float* router = args.in[23] + (size_t)lp * D * NE;
            LAS int* lcnt = (LAS int*)(L + 32768);
            LAS int* lbase = (LAS int*)(L + 32768 + 64);
            LAS int* rec = (LAS int*)(L + 32768 + 128);
            TokInfo* tok = (TokInfo*)(ws + WS_TOK) + (size_t)lp * T;
            int* list = (int*)(ws + WS_LIST) + (size_t)lp * NE * T;
            unsigned char* xn_out = (unsigned char*)YG; gu32* cntw = ctl + CW_CNT + lp * 64;
            for (int rep_ = 0; rep_ < PHREP(13); ++rep_) {
            if (PHREP(13) == 2) { const bool dummy = rep_ == 0;
                tok = dummy ? (TokInfo*)(ws + WS_OM) : (TokInfo*)(ws + WS_TOK) + (size_t)lp * T; list = dummy ? (int*)(ws + WS_OM + 4 * MiB) : (int*)(ws + WS_LIST) + (size_t)lp * NE * T;
                xn_out = dummy ? (unsigned char*)HID : (unsigned char*)YG; cntw = dummy ? ctl + CW_CNT + 128 + lp * 64 : ctl + CW_CNT + lp * 64; }
            f32x4 Ra[4][4], Rb[4][4];
#pragma unroll
            for (int j = 0; j < 4; ++j)
#pragma unroll
                for (int i = 0; i < 4; ++i) { const f32x4* rp = (const f32x4*)(router + (size_t)(4 * lane + 256 * j + i) * NE); Ra[j][i] = rp[0]; Rb[j][i] = rp[1]; }
            f32x4 gg[4];
#pragma unroll
            for (int j = 0; j < 4; ++j) gg[j] = ((const f32x4*)gain + lane)[64 * j];
            for (int tt = bx; tt < T / 128; tt += G) {
                if (tid < 8) lcnt[tid] = 0;
                __syncthreads();
                u32x2 raw[4];
                { const u32x2* xr = (const u32x2*)(XR + (size_t)(tt * 128 + wave * 16) * D) + lane;
#pragma unroll
                  for (int j = 0; j < 4; ++j) raw[j] = xr[64 * j]; }
                for (int q = 0; q < 16; ++q) {
                    const int tl = wave * 16 + q, m = tt * 128 + tl;
                    u32x2 nraw[4];
                    { const u32x2* xr = (const u32x2*)(XR + (size_t)(q + 1 < 16 ? m + 1 : m) * D) + lane;
#pragma unroll
                      for (int j = 0; j < 4; ++j) nraw[j] = xr[64 * j]; }
                    f32x4 v[4];
                    { float sq = 0.f;
#pragma unroll
                      for (int j = 0; j < 4; ++j) { v[j] = bf4_to_f32(raw[j]); sq += (v[j][0] * v[j][0] + v[j][1] * v[j][1]) + (v[j][2] * v[j][2] + v[j][3] * v[j][3]); }
                      const float rstd = 1.0f / sqrtf(wave_sum(sq) * (1.0f / D) + RMS_EPS);
#pragma unroll
                      for (int j = 0; j < 4; ++j) { v[j] = v[j] * rstd * gg[j]; raw[j] = nraw[j]; } }
                    { unsigned* o4 = (unsigned*)(xn_out + (size_t)m * D) + lane;
#pragma unroll
                      for (int j = 0; j < 4; ++j) o4[64 * j] = cvt_pk_fp8x4(v[j][0] * F8_X_MUL, v[j][1] * F8_X_MUL, v[j][2] * F8_X_MUL, v[j][3] * F8_X_MUL); }
                    float lg[8];
#pragma unroll
                    for (int e = 0; e < 8; ++e) lg[e] = 0.f;
#pragma unroll
                    for (int j = 0; j < 4; ++j)
#pragma unroll
                        for (int i = 0; i < 4; ++i) { const f32x4 ra = Ra[j][i], rb = Rb[j][i];
                            const float h = v[j][i];
                            lg[0] += h * ra[0]; lg[1] += h * ra[1]; lg[2] += h * ra[2]; lg[3] += h * ra[3]; lg[4] += h * rb[0]; lg[5] += h * rb[1]; lg[6] += h * rb[2]; lg[7] += h * rb[3]; }
                    {
                        const float a0 = swap32_add(lg[0], lg[4]), a1 = swap32_add(lg[1], lg[5]), a2 = swap32_add(lg[2], lg[6]), a3 = swap32_add(lg[3], lg[7]);
                        const float b0 = row_sum16(swap16_add(a0, a2)), b1 = row_sum16(swap16_add(a1, a3));
                        const int i0 = __float_as_int(b0), i1 = __float_as_int(b1);
                        lg[0] = __int_as_float(__builtin_amdgcn_readlane(i0, 0)); lg[1] = __int_as_float(__builtin_amdgcn_readlane(i1, 0));
                        lg[2] = __int_as_float(__builtin_amdgcn_readlane(i0, 16)); lg[3] = __int_as_float(__builtin_amdgcn_readlane(i1, 16));
                        lg[4] = __int_as_float(__builtin_amdgcn_readlane(i0, 32)); lg[5] = __int_as_float(__builtin_amdgcn_readlane(i1, 32));
                        lg[6] = __int_as_float(__builtin_amdgcn_readlane(i0, 48)); lg[7] = __int_as_float(__builtin_amdgcn_readlane(i1, 48)); }
                    int e1 = 0; float l1 = lg[0];
#pragma unroll
                    for (int e = 1; e < 8; ++e) if (lg[e] > l1) { l1 = lg[e]; e1 = e; }
                    int e2 = -1; float l2 = -INFINITY;
#pragma unroll
                    for (int e = 0; e < 8; ++e) if (e != e1 && lg[e] > l2) { l2 = lg[e]; e2 = e; }
                    if (lane == 0) {
                        const float g1 = 1.0f / (1.0f + __expf(l2 - l1));
                        const int r1 = atomicAdd((int*)&lcnt[e1], 1), r2 = atomicAdd((int*)&lcnt[e2], 1);
                        rec[tl * 4 + 0] = e1; rec[tl * 4 + 1] = e2; rec[tl * 4 + 2] = r1; rec[tl * 4 + 3] = r2;
                        tok[m].g1 = g1; tok[m].g2 = 1.0f - g1;
                    }
                }
                __syncthreads();
                if (tid < 8) lbase[tid] = (int)__hip_atomic_fetch_add(cntw + tid, (unsigned)lcnt[tid], RLX_AGENT);
                __syncthreads();
                if (tid < 128) { const int m = tt * 128 + tid; const int e1 = rec[tid * 4], e2 = rec[tid * 4 + 1]; const int k1 = lbase[e1] + rec[tid * 4 + 2], k2 = lbase[e2] + rec[tid * 4 + 3];
                    list[(size_t)e1 * T + k1] = m; list[(size_t)e2 * T + k2] = m; tok[m].s1 = (e1 << 20) | k1; tok[m].s2 = (e2 << 20) | k2; }
                __syncthreads();
            }
            }
            SEAM(pb + 12);
        }
        if (PHON(14) && IN(pb + 13)) {
        PHASE_IDS;
            pg8::MoeOrder<true, true, F8_X_SC, F8_W_SC + 3> S; load_tb(ctl + CW_CNT + lp * 64, S.tb, S.cnt);
            S.nN = 5632 / 256; S.G = G; S.c = bx; S.K = D; S.Bt = (const unsigned char*)(ws + WS_MGU + (size_t)lp * 8 * (SZ_WGU / 2)); S.bstride = SZ_WGU / 2; S.list = (const int*)(ws + WS_LIST) + (size_t)lp * NE * T;
            pg8::EpiSwiGlu8 E{(unsigned char*)HID, FF};
            for (int rep_ = 0; rep_ < PHREP(14); ++rep_)
            pg8::gemm_phase(wave0, L, (const void*)YG, D, S, E);
            SEAM(pb + 13);
        }
        if (PHON(15) && IN(pb + 14)) {
        PHASE_IDS;
            pg8::MoeOrder<false, true, F8_H_SC> S; load_tb(ctl + CW_CNT + lp * 64, S.tb, S.cnt);
            S.nN = 1024 / 256; S.G = G; S.c = bx; S.K = FF; S.Bt = (const unsigned char*)(ws + WS_MDN + (size_t)lp * 8 * (SZ_WDN / 2)); S.bstride = SZ_WDN / 2; S.list = nullptr; S.rev = 1;
            pg8::EpiBf16Plain E{YM, D};
            for (int rep_ = 0; rep_ < PHREP(15); ++rep_)
            pg8::gemm_phase(wave0, L, HID, FF, S, E);
            SEAM(pb + 14);
        }
    }
    if (PHON(16) && IN(31)) {
        PHASE_IDS;
        int tb[NE + 1], cnt[NE]; load_tb(ctl + CW_CNT + 64, tb, cnt); const TokInfo* tok = (const TokInfo*)(ws + WS_TOK) + (size_t)T;
        for (int m = gw; m < T; m += NGW) norm_rows<true, false, true, 1, true>(XR, nullptr, args.in[3], nullptr, X, m, NGW, lane, tok, YM, tb);
    }
#undef IN
#undef SEAM
}

extern "C" void kernel_launch(void* const* d_in, const int* in_sizes, int n_in, void* d_out, int out_size, void* d_ws, size_t ws_size, hipStream_t stream) {
    static int grid = 0;
    if (grid == 0) {
        if (n_in != 26 || in_sizes[0] != T * D || out_size != T * D || ws_size < WS_END) { fprintf(stderr, "kernel_launch: unexpected shapes (n_in %d, ws %zu < %zu)\n", n_in, ws_size, (size_t)WS_END); grid = -1; return; }
        int dev = 0, cus = 0, per_cu = 0;
        if (hipGetDevice(&dev) != hipSuccess || hipDeviceGetAttribute(&cus, hipDeviceAttributeMultiprocessorCount, dev) != hipSuccess) { grid = -1; return; }
        if (hipFuncSetAttribute((const void*)trunk_fwd, hipFuncAttributeMaxDynamicSharedMemorySize, LDS_BYTES) != hipSuccess) { fprintf(stderr, "kernel_launch: hipFuncSetAttribute failed\n"); grid = -1; return; }
        if (hipOccupancyMaxActiveBlocksPerMultiprocessor(&per_cu, (const void*)trunk_fwd, NWAVES * 64, LDS_BYTES) != hipSuccess || per_cu < 1) { fprintf(stderr, "kernel_launch: occupancy query reports %d\n", per_cu); }
        (void)hipGetLastError();
        grid = cus;
    }
    if (grid < 0) return;
    (void)hipMemsetAsync((char*)d_ws + WS_CTL, 0, CTL_ZERO_BYTES, stream);
    Args a{};
    for (int i = 0; i < 26; ++i) a.in[i] = (const float*)d_in[i];
    a.out = (float*)d_out; a.ws = (unsigned char*)d_ws;
#if MK_PER_PHASE
    for (int p = 0; p < N_PHASES; ++p) { a.ph_lo = p; a.ph_hi = p + 1; hipLaunchKernelGGL(trunk_fwd, dim3(grid), dim3(NWAVES * 64), LDS_BYTES, stream, a); }
#else
    a.ph_lo = 0; a.ph_hi = N_PHASES;
    hipLaunchKernelGGL(trunk_fwd, dim3(grid), dim3(NWAVES * 64), LDS_BYTES, stream, a);
#endif
}
```
